# Optimizing an MI355X kernel written in HIP

```python
import jax, jax.numpy as jnp
from jax import lax
import numpy as np

D_MODEL = 1024
BATCH = 8
SEQ = 2048
DEPTH = 2
DEC_BATCH = 128
DEC_SEQ = 1
PAST_LEN = 16384
PAGE_SIZE = 128

N_MIXERS = 2
N_A_LAYERS = (DEPTH + N_MIXERS - 1) // N_MIXERS
N_B_LAYERS = DEPTH // N_MIXERS
SG_CHUNK = 128
SG_WIDTH = 2 * D_MODEL
SG_GROUPS = 8
SG_GROUP_DIM = SG_WIDTH // SG_GROUPS
GLA_HEADS = 4
GLA_KEY_DIM = D_MODEL // 2
GLA_VALUE_DIM = D_MODEL
GLA_HEAD_K = GLA_KEY_DIM // GLA_HEADS
GLA_HEAD_V = GLA_VALUE_DIM // GLA_HEADS
GLA_GATE_RANK = 16
GLA_GATE_NORMALIZER = 16.0
GLA_CHUNK = 64
GLA_IN_DIM = 2 * GLA_KEY_DIM + 2 * GLA_VALUE_DIM + GLA_GATE_RANK
D_FF = ((8 * D_MODEL + 3 * 256 - 1) // (3 * 256)) * 256
EPS = 1e-6

kernel_name = "hybrid_sgu_gla_decoder_step"


def rms_norm(x, g):
    xf = x.astype(jnp.float32)
    y = xf * lax.rsqrt(jnp.mean(xf * xf, axis=-1, keepdims=True) + EPS)
    return (y * g.astype(jnp.float32)).astype(x.dtype)


def layer_norm(x, g, b):
    xf = x.astype(jnp.float32)
    mu = jnp.mean(xf, axis=-1, keepdims=True)
    var = jnp.mean(jnp.square(xf - mu), axis=-1, keepdims=True)
    y = (xf - mu) * lax.rsqrt(var + EPS)
    return (y * g.astype(jnp.float32) + b.astype(jnp.float32)).astype(x.dtype)


def swiglu(x, w13, w2):
    a, b = jnp.split(x @ w13, 2, axis=-1)
    return (jax.nn.silu(a) * b) @ w2


def spatial_gate_mixer(x, w_in, ln_g, ln_b, w_s, b_s, w_out):
    B, L, _ = x.shape
    z = jax.nn.gelu(x @ w_in, approximate=False)
    u, v = jnp.split(z, 2, axis=-1)
    v = layer_norm(v, ln_g, ln_b)
    cw = min(SG_CHUNK, L)
    n_chunks = -(-L // cw)
    lp = n_chunks * cw
    vp = jnp.pad(v, ((0, 0), (0, lp - L), (0, 0))).reshape(B, n_chunks, cw, SG_GROUPS, SG_GROUP_DIM)
    mask = jnp.tril(jnp.ones((cw, cw), dtype=bool))
    ws = jnp.where(mask, w_s[:, :cw, :cw], 0).astype(v.dtype)
    bias = b_s[:, :cw].T[:, :, None].astype(v.dtype)
    mixed = jnp.einsum('gts,bnsgc->bntgc', ws, vp) + bias
    mixed = mixed.reshape(B, lp, SG_WIDTH)[:, :L]
    y = (u * mixed) @ w_out
    n_last = (L - 1) % SG_CHUNK + 1
    return y, v[:, L - n_last:]


def gla_chunk_scan(q, k, v, g, s0):
    B, L = q.shape[:2]
    c = min(GLA_CHUNK, L)
    n = -(-L // c)
    lp = n * c

    def blocks(a):
        a = jnp.pad(a, ((0, 0), (0, lp - L), (0, 0), (0, 0)))
        return a.reshape(B, n, c, a.shape[2], a.shape[3]).transpose(1, 0, 3, 2, 4)

    qc, kc, vc, gc = blocks(q), blocks(k), blocks(v), blocks(g)
    mask = jnp.tril(jnp.ones((c, c), dtype=bool))[:, :, None]

    def step(S, inp):
        qi, ki, vi, gi = inp
        b = jnp.cumsum(gi, axis=2)
        o_inter = jnp.einsum('bhtk,bhkv->bhtv', qi * jnp.exp(b), S)
        diff = b[:, :, :, None, :] - b[:, :, None, :, :]
        decay = jnp.exp(jnp.where(mask, diff, -jnp.inf))
        attn = jnp.einsum('bhtk,bhsk,bhtsk->bhts', qi, ki, decay)
        o = o_inter + jnp.einsum('bhts,bhsv->bhtv', attn, vi)
        b_last = b[:, :, -1:, :]
        k_dec = ki * jnp.exp(b_last - b)
        S = jnp.exp(b_last[:, :, 0, :])[..., None] * S + jnp.einsum('bhsk,bhsv->bhkv', k_dec, vi)
        return S, o

    S, o = lax.scan(step, s0, (qc, kc, vc, gc))
    o = o.transpose(1, 0, 3, 2, 4).reshape(B, lp, GLA_HEADS, GLA_HEAD_V)[:, :L]
    return o, S


def gla_mixer(x, w_in, w_gate_up, b_gate, out_norm_g, w_out, s0):
    B, L, _ = x.shape
    proj = x @ w_in
    q, k, v, g_out, r = jnp.split(
        proj, [GLA_KEY_DIM, 2 * GLA_KEY_DIM, 2 * GLA_KEY_DIM + GLA_VALUE_DIM, 2 * GLA_KEY_DIM + 2 * GLA_VALUE_DIM], axis=-1)
    log_a = jax.nn.log_sigmoid((r @ w_gate_up + b_gate).astype(jnp.float32)) / GLA_GATE_NORMALIZER
    heads_k = lambda a: a.astype(jnp.float32).reshape(B, L, GLA_HEADS, GLA_HEAD_K)
    qh = heads_k(q) * (GLA_HEAD_K ** -0.5)
    kh = heads_k(k)
    gh = heads_k(log_a)
    vh = v.astype(jnp.float32).reshape(B, L, GLA_HEADS, GLA_HEAD_V)
    o, S = gla_chunk_scan(qh, kh, vh, gh, s0)
    o = rms_norm(o, out_norm_g).reshape(B, L, GLA_VALUE_DIM).astype(x.dtype)
    o = o * jax.nn.silu(g_out)
    return o @ w_out, S


def trunk(x, gla_init, norm_g, ffn_w13, ffn_w2, sg_w_in, sg_ln_g, sg_ln_b, sg_w_s, sg_b_s, sg_w_out,
          gla_w_in, gla_w_gate_up, gla_b_gate, gla_out_norm_g, gla_w_out):
    v_rows, gla_states = [], []
    for i in range(DEPTH):
        j = i // N_MIXERS
        h = rms_norm(x, norm_g[i, 0])
        if i % N_MIXERS == 0:
            m, vr = spatial_gate_mixer(h, sg_w_in[j], sg_ln_g[j], sg_ln_b[j], sg_w_s[j], sg_b_s[j], sg_w_out[j])
            v_rows.append(vr)
        else:
            m, S = gla_mixer(h, gla_w_in[j], gla_w_gate_up[j], gla_b_gate[j], gla_out_norm_g[j], gla_w_out[j], gla_init[j])
            gla_states.append(S)
        x = x + rms_norm(m, norm_g[i, 1])
        h = rms_norm(x, norm_g[i, 2])
        x = x + rms_norm(swiglu(h, ffn_w13[i], ffn_w2[i]), norm_g[i, 3])
    return x, jnp.stack(v_rows), jnp.stack(gla_states)


def setup_inputs(seed: int = 0) -> dict:
    key = jax.random.key(seed)
    ks = jax.random.split(key, 20)
    nrm = lambda k, shape, s: jax.random.normal(k, shape, jnp.float32) * s
    return {
        "x_prompt": nrm(ks[0], (BATCH, SEQ, D_MODEL), 1.0),
        "x_sample": nrm(ks[1], (DEC_BATCH, DEC_SEQ, D_MODEL), 1.0),
        "state_gla": nrm(ks[2], (N_B_LAYERS, DEC_BATCH, GLA_HEADS, GLA_HEAD_K, GLA_HEAD_V), 1.0),
        "norm_g": 1.0 + nrm(ks[3], (DEPTH, 4, D_MODEL), 0.1),
        "ffn_w13": nrm(ks[4], (DEPTH, D_MODEL, 2 * D_FF), D_MODEL ** -0.5),
        "ffn_w2": nrm(ks[5], (DEPTH, D_FF, D_MODEL), D_FF ** -0.5),
        "sg_w_in": nrm(ks[6], (N_A_LAYERS, D_MODEL, 2 * SG_WIDTH), D_MODEL ** -0.5),
        "sg_ln_g": 1.0 + nrm(ks[7], (N_A_LAYERS, SG_WIDTH), 0.1),
        "sg_ln_b": nrm(ks[8], (N_A_LAYERS, SG_WIDTH), 0.02),
        "sg_w_s": nrm(ks[9], (N_A_LAYERS, SG_GROUPS, SG_CHUNK, SG_CHUNK), SG_CHUNK ** -0.5),
        "sg_b_s": 1.0 + nrm(ks[10], (N_A_LAYERS, SG_GROUPS, SG_CHUNK), 0.1),
        "sg_w_out": nrm(ks[11], (N_A_LAYERS, SG_WIDTH, D_MODEL), SG_WIDTH ** -0.5),
        "gla_w_in": nrm(ks[12], (N_B_LAYERS, D_MODEL, GLA_IN_DIM), D_MODEL ** -0.5),
        "gla_w_gate_up": nrm(ks[13], (N_B_LAYERS, GLA_GATE_RANK, GLA_KEY_DIM), GLA_GATE_RANK ** -0.5),
        "gla_b_gate": nrm(ks[14], (N_B_LAYERS, GLA_KEY_DIM), 0.1),
        "gla_out_norm_g": 1.0 + nrm(ks[15], (N_B_LAYERS, GLA_HEAD_V), 0.1),
        "gla_w_out": nrm(ks[16], (N_B_LAYERS, GLA_VALUE_DIM, D_MODEL), GLA_VALUE_DIM ** -0.5),
    }


def reference(x_prompt, x_sample, state_gla, norm_g, ffn_w13, ffn_w2, sg_w_in, sg_ln_g, sg_ln_b, sg_w_s,
              sg_b_s, sg_w_out, gla_w_in, gla_w_gate_up, gla_b_gate, gla_out_norm_g, gla_w_out):
    zero_state = jnp.zeros((N_B_LAYERS, x_prompt.shape[0], GLA_HEADS, GLA_HEAD_K, GLA_HEAD_V), jnp.float32)
    y_prompt, sg_v_prompt, gla_state_prompt = trunk(
        x_prompt, zero_state, norm_g, ffn_w13, ffn_w2, sg_w_in, sg_ln_g, sg_ln_b, sg_w_s, sg_b_s, sg_w_out,
        gla_w_in, gla_w_gate_up, gla_b_gate, gla_out_norm_g, gla_w_out)
    y_sample, sg_v_sample, gla_state_sample = trunk(
        x_sample, state_gla.astype(jnp.float32), norm_g, ffn_w13, ffn_w2, sg_w_in, sg_ln_g, sg_ln_b, sg_w_s, sg_b_s,
        sg_w_out, gla_w_in, gla_w_gate_up, gla_b_gate, gla_out_norm_g, gla_w_out)
    return (y_prompt, y_sample, sg_v_prompt, sg_v_sample,
            gla_state_prompt.astype(x_prompt.dtype), gla_state_sample.astype(state_gla.dtype))
```

```cpp
#include <hip/hip_runtime.h>
#include <hip/hip_cooperative_groups.h>
#include <cstdio>
namespace cg = cooperative_groups;

namespace pg8 {
#define PG8_LAS __attribute__((address_space(3)))
typedef unsigned short bf16_t;
typedef short bf16x8 __attribute__((ext_vector_type(8)));
typedef float f32x4 __attribute__((ext_vector_type(4)));
typedef unsigned u32x4 __attribute__((ext_vector_type(4)));
constexpr int BM = 256, BK = 64, HALF = 128, HTB = HALF * BK * 2  , STAGE_BYTES = 8 * HTB, NXCD = 8, WGM = 8;

__host__ __device__ __forceinline__ int lds_byte(int r, int c) { const int st = (r >> 4) * 2 + (c >> 5), rr = r & 15, cc = c & 31, ob = rr * 64 + cc * 2; return st * 1024 + (ob ^ (((ob >> 9) & 1) << 5)); }
__host__ __device__ __forceinline__ void stage_rc(int b, int& R, int& C) { const int st = b / 1024, sb = b % 1024, swz = sb ^ (((sb >> 9) & 1) << 5); R = (st >> 1) * 16 + swz / 64; C = (st & 1) * 32 + (swz % 64) / 2; }
__host__ __device__ __forceinline__ int perm32(int rho) { const int n = rho >> 4, i = rho & 15; return 8 * (i >> 2) + 4 * n + (i & 3); }

struct Unit { int pm, pn; };
struct Gemm { const bf16_t* A; const bf16_t* Bt; int M, N, K; };

struct StaticOrder {
    int nM, nN, nwg, G, c;
    __host__ __device__ void init(int M, int N, int G_, int c_) { nM = M / BM; nN = N / BM; nwg = nM * nN; G = G_; c = c_; }
    __host__ __device__ bool next(int i, Unit& u) const {
        const long L = (long)i * G + c; if (L >= nwg) return false;
        int wgid = (int)L; { const int q = nwg / NXCD, r = nwg % NXCD, xcd = wgid % NXCD, off = wgid / NXCD; wgid = (xcd < r ? xcd * (q + 1) : r * (q + 1) + (xcd - r) * q) + off; }
        const int nig = WGM * nN, gid = wgid / nig, fm = gid * WGM, gsz = (nM - fm) < WGM ? (nM - fm) : WGM;
        u.pm = fm + ((wgid % nig) % gsz); u.pn = (wgid % nig) / gsz; return true;
    }
    __device__ __forceinline__ void a_ready(const Unit&) const {}
    __device__ __forceinline__ void done(const Unit&) const {}
};
__device__ __forceinline__ unsigned cvt_pk_bf16(float lo, float hi) { unsigned r; asm volatile("v_cvt_pk_bf16_f32 %0, %1, %2" : "=v"(r) : "v"(lo), "v"(hi)); return r; }
typedef float f32x2 __attribute__((ext_vector_type(2)));
__device__ __forceinline__ f32x2 gelu_pk(f32x2 v) {
    const f32x2 av = __builtin_elementwise_abs(v), d = av * 0.2316418882f + 1.0f;
    f32x2 t; t.x = __builtin_amdgcn_rcpf(d.x); t.y = __builtin_amdgcn_rcpf(d.y);
    f32x2 q = t * 0.5307027145f + (-0.7265760135f); q = q * t + 0.7107068705f; q = q * t + (-0.142248368f); q = q * t + 0.127414796f; q = q * t;
    const f32x2 s = (v * v) * (-0.72134752044f);
    f32x2 e; e.x = __builtin_amdgcn_exp2f(s.x); e.y = __builtin_amdgcn_exp2f(s.y);
    const f32x2 m = v * (q * e), r = v - m;
    f32x2 o; o.x = v.x < 0.f ? m.x : r.x; o.y = v.y < 0.f ? m.y : r.y; return o;
}
typedef unsigned long long u64_t;
__device__ __forceinline__ float bf2f(unsigned short b) { return __uint_as_float(((unsigned)b) << 16); }
__device__ __forceinline__ float silu_f(float x) { return x * __builtin_amdgcn_rcpf(1.0f + __expf(-x)); }

struct EpiStoreBf16 {
    static constexpr bool PERM = true, AFTER_DRAIN = false;
    bf16_t* O; int ldc;
    __device__ __forceinline__ void operator()(const f32x4 (&acc)[2][2][4][2], const Unit& u, int wr, int wc, int fr, int fq) const {
        const int row0 = u.pm * BM + wr * 64 + fr, col0 = u.pn * BM + wc * 32 + 8 * fq;
#pragma unroll
        for (int ai = 0; ai < 2; ++ai)
#pragma unroll
            for (int m = 0; m < 4; ++m) { bf16_t* rowp = O + (size_t)(row0 + ai * HALF + m * 16) * ldc + col0;
#pragma unroll
                for (int bj = 0; bj < 2; ++bj) { const f32x4 v0 = acc[ai][bj][m][0], v1 = acc[ai][bj][m][1];
                    u32x4 w; w.x = cvt_pk_bf16(v0[0], v0[1]); w.y = cvt_pk_bf16(v0[2], v0[3]); w.z = cvt_pk_bf16(v1[0], v1[1]); w.w = cvt_pk_bf16(v1[2], v1[3]);
                    *(u32x4*)(rowp + bj * HALF) = w; } }
    }
};
struct EpiSgIn {
    static constexpr bool PERM = true, AFTER_DRAIN = false;
    bf16_t* U; bf16_t* V; float* stats;
    __device__ __forceinline__ void operator()(const f32x4 (&acc)[2][2][4][2], const Unit& u, int wr, int wc, int fr, int fq) const {
        const bool isv = u.pn >= 8; bf16_t* base = isv ? V : U;
        const int row0 = u.pm * BM + wr * 64 + fr, col0 = (u.pn & 7) * BM + wc * 32 + 8 * fq;
#pragma unroll
        for (int ai = 0; ai < 2; ++ai)
#pragma unroll
            for (int m = 0; m < 4; ++m) { const int row = row0 + ai * HALF + m * 16; bf16_t* rowp = base + (size_t)row * 2048 + col0; float s = 0.f, q = 0.f;
#pragma unroll
                for (int bj = 0; bj < 2; ++bj) { f32x4 v0 = acc[ai][bj][m][0], v1 = acc[ai][bj][m][1];
                    f32x2 a = gelu_pk((f32x2){v0[0], v0[1]}), b = gelu_pk((f32x2){v0[2], v0[3]}), c = gelu_pk((f32x2){v1[0], v1[1]}), d = gelu_pk((f32x2){v1[2], v1[3]});
                    s += (a.x + a.y) + (b.x + b.y) + (c.x + c.y) + (d.x + d.y);
                    q += (a.x * a.x + a.y * a.y) + (b.x * b.x + b.y * b.y) + (c.x * c.x + c.y * c.y) + (d.x * d.x + d.y * d.y);
                    u32x4 w; w.x = cvt_pk_bf16(a.x, a.y); w.y = cvt_pk_bf16(b.x, b.y); w.z = cvt_pk_bf16(c.x, c.y); w.w = cvt_pk_bf16(d.x, d.y);
                    *(u32x4*)(rowp + bj * HALF) = w; }
                if (isv) { s += __shfl_xor(s, 16); s += __shfl_xor(s, 32); q += __shfl_xor(q, 16); q += __shfl_xor(q, 32);
                    if (fq == 0) *(f32x2*)(stats + ((size_t)row * 32 + (u.pn - 8) * 4 + wc) * 2) = (f32x2){s, q}; } }
    }
};
struct EpiSwiglu {
    static constexpr bool PERM = true, AFTER_DRAIN = false;
    bf16_t* O;
    __device__ __forceinline__ void operator()(const f32x4 (&acc)[2][2][4][2], const Unit& u, int wr, int wc, int fr, int fq) const {
        const int row0 = u.pm * BM + wr * 64 + fr, col0 = u.pn * 128 + wc * 32 + 8 * fq;
#pragma unroll
        for (int ai = 0; ai < 2; ++ai)
#pragma unroll
            for (int m = 0; m < 4; ++m) { bf16_t* rowp = O + (size_t)(row0 + ai * HALF + m * 16) * 2816 + col0;
                const f32x4 a0 = acc[ai][0][m][0], a1 = acc[ai][0][m][1], b0 = acc[ai][1][m][0], b1 = acc[ai][1][m][1];
                u32x4 w; w.x = cvt_pk_bf16(silu_f(a0[0]) * b0[0], silu_f(a0[1]) * b0[1]); w.y = cvt_pk_bf16(silu_f(a0[2]) * b0[2], silu_f(a0[3]) * b0[3]);
                w.z = cvt_pk_bf16(silu_f(a1[0]) * b1[0], silu_f(a1[1]) * b1[1]); w.w = cvt_pk_bf16(silu_f(a1[2]) * b1[2], silu_f(a1[3]) * b1[3]);
                *(u32x4*)rowp = w; }
    }
};

template <class Epi, class Sched, bool STAMP = false>
__device__ __forceinline__ void gemm_phase(PG8_LAS unsigned char* lds, const Gemm g, const Sched& S, const Epi& E, unsigned long long* stamps) {
    const int tid = threadIdx.x, wid = __builtin_amdgcn_readfirstlane(tid >> 6), lane = tid & 63, wr = wid >> 2, wc = wid & 3, fr = lane & 15, fq = lane >> 4;
    const int K = g.K, nt = K / BK;
    int ts_lo = 0, ts_hi = 0, nts = 0; const unsigned long long rt_entry = STAMP ? (unsigned long long)wall_clock64() : 0ull;
#define PG8_STAMP() do { if (STAMP && wid == 0 && nts < 64) { const unsigned long long _c = (unsigned long long)clock64(); \
        ts_lo = (lane == nts) ? (int)(unsigned)_c : ts_lo; ts_hi = (lane == nts) ? (int)(unsigned)(_c >> 32) : ts_hi; ++nts; } } while (0)
    PG8_STAMP();
    unsigned voffA[2], voffB[2];
#pragma unroll
    for (int i = 0; i < 2; ++i) { int R, C; stage_rc(tid * 16 + i * 8192, R, C); const int Rb = Epi::PERM ? ((R & ~31) + perm32(R & 31)) : R;
        voffA[i] = (unsigned)(R * K + C) * 2u; voffB[i] = (unsigned)(Rb * K + C) * 2u; }
    const size_t kstep = (size_t)(BK * 2);
    const size_t hstep = (size_t)HALF * K * 2;
    const size_t tstep = 2 * hstep;
    const unsigned ldsw = (unsigned)wid * 1024u;
    const int aoff = lds_byte(wr * 64 + fr, fq * 8), boff = lds_byte(wc * 32 + fr, fq * 8);
#define PG8_SA(b, h) (((b) * 2 + (h)) * HTB)
#define PG8_SB(b, h) ((4 + (b) * 2 + (h)) * HTB)
#define PG8_STAGE(bufoff, gbase, voff) do { _Pragma("unroll") for (int _i = 0; _i < 2; ++_i) \
        __builtin_amdgcn_global_load_lds((const unsigned*)((const char*)(gbase) + (voff)[_i]), (PG8_LAS unsigned*)(lds + (bufoff) + ldsw + _i * 8192), 16, 0, 0); } while (0)
#define PG8_LDA(dst, b, h) do { _Pragma("unroll") for (int m = 0; m < 4; ++m) _Pragma("unroll") for (int k = 0; k < 2; ++k) dst[m][k] = *(const PG8_LAS bf16x8*)(lds + PG8_SA(b, h) + aoff + m * 2048 + k * 1024); } while (0)
#define PG8_LDB(dst, b, h) do { _Pragma("unroll") for (int n = 0; n < 2; ++n) _Pragma("unroll") for (int k = 0; k < 2; ++k) dst[n][k] = *(const PG8_LAS bf16x8*)(lds + PG8_SB(b, h) + boff + n * 2048 + k * 1024); } while (0)
#define PG8_MMA(ai, bj, At, Bt) do { __builtin_amdgcn_s_setprio(1); _Pragma("unroll") for (int m = 0; m < 4; ++m) _Pragma("unroll") for (int n = 0; n < 2; ++n) _Pragma("unroll") for (int k = 0; k < 2; ++k) \
        acc[ai][bj][m][n] = __builtin_amdgcn_mfma_f32_16x16x32_bf16(Bt[n][k], At[m][k], acc[ai][bj][m][n], 0, 0, 0); __builtin_amdgcn_s_setprio(0); } while (0)
#define PG8_WAIT_V(n) asm volatile("s_waitcnt vmcnt(" #n ")" ::: "memory")
#define PG8_WAIT_L(n) asm volatile("s_waitcnt lgkmcnt(" #n ")" ::: "memory")
#define PG8_BAR __builtin_amdgcn_s_barrier()
#define PG8_SCHED __builtin_amdgcn_sched_barrier(0)
    Unit cur, nxt; int ui = 0;
    if (!S.next(0, cur)) return;
    f32x4 acc[2][2][4][2];
#pragma unroll
    for (int a = 0; a < 2; ++a)
#pragma unroll
        for (int b = 0; b < 2; ++b)
#pragma unroll
            for (int m = 0; m < 4; ++m)
#pragma unroll
                for (int n = 0; n < 2; ++n) acc[a][b][m][n] = (f32x4){0.f, 0.f, 0.f, 0.f};
    bf16x8 At[4][2], B0[2][2], B1[2][2];
    const char* cA = (const char*)g.A + (size_t)cur.pm * tstep; const char* cB = (const char*)g.Bt + (size_t)cur.pn * tstep;
    S.a_ready(cur);
    PG8_STAGE(PG8_SB(0, 0), cB, voffB); PG8_STAGE(PG8_SA(0, 0), cA, voffA); PG8_STAGE(PG8_SB(0, 1), cB + hstep, voffB); PG8_STAGE(PG8_SA(0, 1), cA + hstep, voffA);
    if (wr == 1) PG8_BAR;
    PG8_WAIT_V(4); PG8_BAR;
    PG8_STAGE(PG8_SB(1, 0), cB + kstep, voffB); PG8_STAGE(PG8_SA(1, 0), cA + kstep, voffA); PG8_STAGE(PG8_SB(1, 1), cB + hstep + kstep, voffB);
    PG8_WAIT_V(6); PG8_BAR;
    PG8_STAMP();
    for (;;) {
        const bool has_next = S.next(ui + 1, nxt);
        const char* nA = has_next ? (const char*)g.A + (size_t)nxt.pm * tstep : cA; const char* nB = has_next ? (const char*)g.Bt + (size_t)nxt.pn * tstep : cB;
        for (int t = 0; t < nt; t += 2) {
            const bool last = (t == nt - 2);
            const char* a1 = cA + (size_t)(t + 1) * kstep;
            const char* a2 = last ? nA : cA + (size_t)(t + 2) * kstep; const char* b2 = last ? nB : cB + (size_t)(t + 2) * kstep;
            const char* a3 = a2 + kstep; const char* b3 = b2 + kstep;
            if (last && has_next) S.a_ready(nxt);
            PG8_LDB(B0, 0, 0); PG8_SCHED; PG8_LDA(At, 0, 0); PG8_STAGE(PG8_SA(1, 1), a1 + hstep, voffA);
            PG8_WAIT_L(8); PG8_BAR; PG8_WAIT_L(0); PG8_MMA(0, 0, At, B0); PG8_BAR; PG8_SCHED;
            PG8_LDB(B1, 0, 1); PG8_STAGE(PG8_SB(0, 0), b2, voffB);
            PG8_BAR; PG8_WAIT_L(0); PG8_MMA(0, 1, At, B1); PG8_BAR;
            PG8_LDA(At, 0, 1); PG8_STAGE(PG8_SA(0, 0), a2, voffA);
            PG8_BAR; PG8_WAIT_L(0); PG8_MMA(1, 0, At, B0); PG8_BAR; PG8_SCHED;
            PG8_STAGE(PG8_SB(0, 1), b2 + hstep, voffB);
            PG8_WAIT_V(6); PG8_BAR; PG8_MMA(1, 1, At, B1); PG8_BAR;
            PG8_LDB(B0, 1, 0); PG8_SCHED; PG8_LDA(At, 1, 0); PG8_STAGE(PG8_SA(0, 1), a2 + hstep, voffA);
            PG8_WAIT_L(8); PG8_BAR; PG8_WAIT_L(0); PG8_MMA(0, 0, At, B0); PG8_BAR; PG8_SCHED;
            PG8_LDB(B1, 1, 1); PG8_STAGE(PG8_SB(1, 0), b3, voffB);
            PG8_BAR; PG8_WAIT_L(0); PG8_MMA(0, 1, At, B1); PG8_BAR;
            PG8_LDA(At, 1, 1); PG8_STAGE(PG8_SA(1, 0), a3, voffA);
            PG8_BAR; PG8_WAIT_L(0); PG8_MMA(1, 0, At, B0); PG8_BAR; PG8_SCHED;
            PG8_STAGE(PG8_SB(1, 1), b3 + hstep, voffB);
            PG8_WAIT_V(6); PG8_BAR; PG8_MMA(1, 1, At, B1); PG8_BAR;
        }
        PG8_STAMP();
        if constexpr (!Epi::AFTER_DRAIN) { E(acc, cur, wr, wc, fr, fq); S.done(cur); }
        PG8_STAMP();
        if (!has_next) break;
#pragma unroll
        for (int a = 0; a < 2; ++a)
#pragma unroll
            for (int b = 0; b < 2; ++b)
#pragma unroll
                for (int m = 0; m < 4; ++m)
#pragma unroll
                    for (int n = 0; n < 2; ++n) acc[a][b][m][n] = (f32x4){0.f, 0.f, 0.f, 0.f};
        cur = nxt; cA = nA; cB = nB; ++ui;
    }
    PG8_WAIT_V(0);
    if (wr == 0) PG8_BAR;
    PG8_BAR;
    if constexpr (Epi::AFTER_DRAIN) { E.fused(acc, cur, wr, wc, fr, fq, lds, wid, lane); S.done(cur); }
    PG8_STAMP();
    if (STAMP && wid == 0) { stamps[lane] = lane < nts ? (((unsigned long long)(unsigned)ts_hi << 32) | (unsigned)ts_lo) : 0ull;
        if (lane == 62) stamps[62] = rt_entry; if (lane == 63) stamps[63] = (unsigned long long)wall_clock64(); }
#undef PG8_STAMP
#undef PG8_SA
#undef PG8_SB
#undef PG8_STAGE
#undef PG8_LDA
#undef PG8_LDB
#undef PG8_MMA
#undef PG8_WAIT_V
#undef PG8_WAIT_L
#undef PG8_BAR
#undef PG8_SCHED
}
}

using pg8::bf16_t; using pg8::bf16x8; using pg8::f32x4; using pg8::u32x4; using pg8::cvt_pk_bf16; using pg8::bf2f; using pg8::silu_f;
typedef unsigned u32x2 __attribute__((ext_vector_type(2)));
constexpr int DM = 1024, MPR = 16384, MSM = 128, MTOT = MPR + MSM, MP = 16640, SEQ = 2048;
constexpr int DFF = 2816, SGW = 2048;
constexpr float EPSN = 1e-6f;
constexpr int LDS_BYTES = 131072;
constexpr size_t O_Y = 0, O_SGVP = (size_t)MTOT * DM, O_SGVS = O_SGVP + (size_t)8 * 128 * 2048, O_STP = O_SGVS + (size_t)128 * 2048, O_STS = O_STP + (size_t)8 * 4 * 128 * 256;
constexpr size_t al256(size_t x) { return (x + 255) & ~(size_t)255; }
constexpr size_t W_SGIN = 0;
constexpr size_t W_SGOUT = W_SGIN + (size_t)4096 * 1024 * 2;
constexpr size_t W_13_0 = W_SGOUT + (size_t)1024 * 2048 * 2;
constexpr size_t W_2_0 = W_13_0 + (size_t)5632 * 1024 * 2;
constexpr size_t W_13_1 = W_2_0 + (size_t)1024 * 2816 * 2;
constexpr size_t W_2_1 = W_13_1 + (size_t)5632 * 1024 * 2;
constexpr size_t W_GLAIN = W_2_1 + (size_t)1024 * 2816 * 2;
constexpr size_t W_R = W_GLAIN + (size_t)3072 * 1024 * 2;
constexpr size_t W_GLAOUT = W_R + (size_t)32 * 1024 * 2;
constexpr size_t WS_HB = W_GLAOUT + (size_t)1024 * 1024 * 2;
constexpr size_t WS_R1 = WS_HB + (size_t)MP * 1024 * 2;
constexpr size_t WS_MBUF = WS_R1 + (size_t)MP * 3072 * 2;
constexpr size_t WS_RBUF = WS_R1 + (size_t)MP * 4096 * 2;
constexpr size_t WS_STATS = WS_RBUF + (size_t)MP * 16 * 4;
constexpr size_t WS_KDT = al256(WS_STATS + (size_t)MP * 32 * 2 * 4);
constexpr size_t WS_DLAST = WS_KDT + (size_t)1024 * 128 * 64 * 2;
constexpr size_t WS_END = WS_DLAST + (size_t)1024 * 128 * 4;
constexpr size_t WS_QB = W_SGIN;
constexpr size_t WS_ATT = WS_QB + (size_t)MPR * 512 * 2;
static_assert(WS_ATT + (size_t)1024 * 64 * 64 * 2 <= W_13_1, "GLA temporaries overflow the layer-0 weights");
static_assert(WS_END <= (size_t)256 * 1024 * 1024, "workspace too large");
static_assert((size_t)1024 * 256 * 64 * 2 <= (size_t)MP * 1024 * 2, "VT must fit the MBUF region");

struct Params {
    const float *x_prompt, *x_sample, *state_gla, *norm_g, *ffn_w13, *ffn_w2, *sg_w_in, *sg_ln_g, *sg_ln_b, *sg_w_s, *sg_b_s, *sg_w_out,
                *gla_w_in, *gla_w_gate_up, *gla_b_gate, *gla_out_norm_g, *gla_w_out;
    float* out; unsigned char* ws;
};

__device__ __forceinline__ float wave_sum(float v) {
#pragma unroll
    for (int o = 1; o < 64; o <<= 1) v += __shfl_xor(v, o);
    return v;
}
#define LDS_WAIT() asm volatile("s_waitcnt lgkmcnt(0)" ::: "memory")

__device__ __forceinline__ void transpose_item(const float* __restrict__ W, int ldw, int cmax, bf16_t* __restrict__ WT, int K, int k0, int c0, int n0, float* scr, int lane) {
    const int c = c0 + (lane & 31); const bool ok = c < cmax;
#pragma unroll 8
    for (int i = 0; i < 32; ++i) { const int kk = 2 * i + (lane >> 5); scr[kk * 33 + (lane & 31)] = ok ? W[(size_t)(k0 + kk) * ldw + c] : 0.f; }
    LDS_WAIT();
    const int cc = lane & 7;
#pragma unroll
    for (int j = 0; j < 4; ++j) { const int n = (lane >> 3) + 8 * j; const float* s = scr + (8 * cc) * 33 + n;
        u32x4 o; o.x = cvt_pk_bf16(s[0 * 33], s[1 * 33]); o.y = cvt_pk_bf16(s[2 * 33], s[3 * 33]); o.z = cvt_pk_bf16(s[4 * 33], s[5 * 33]); o.w = cvt_pk_bf16(s[6 * 33], s[7 * 33]);
        *(u32x4*)(WT + (size_t)(n0 + n) * K + k0 + 8 * cc) = o; }
    LDS_WAIT();
}

__device__ __forceinline__ const float* x_in_row(const Params& p, int row) { return row < MPR ? p.x_prompt + (size_t)row * DM : p.x_sample + (size_t)(row - MPR) * DM; }

__device__ __forceinline__ void norm_phase(const Params& p, int mode, const float* __restrict__ g_res, const float* __restrict__ g_h, bool x_from_input) {
    const int lane = threadIdx.x & 63, wave = threadIdx.x >> 6;
    const bf16_t* MB = (const bf16_t*)(p.ws + WS_MBUF); bf16_t* HB = (bf16_t*)(p.ws + WS_HB);
    for (int row = blockIdx.x * 8 + wave; row < MTOT; row += gridDim.x * 8) {
        const float* xin = x_from_input ? x_in_row(p, row) : (const float*)(p.out + (size_t)row * DM);
        f32x4 v[4];
#pragma unroll
        for (int j = 0; j < 4; ++j) v[j] = *(const f32x4*)(xin + 4 * lane + 256 * j);
        if (mode != 0) {
            f32x4 mv[4]; float ss = 0.f;
#pragma unroll
            for (int j = 0; j < 4; ++j) { const u32x2 w = *(const u32x2*)(MB + (size_t)row * DM + 4 * lane + 256 * j);
                mv[j] = (f32x4){__uint_as_float(w.x << 16), __uint_as_float(w.x & 0xffff0000u), __uint_as_float(w.y << 16), __uint_as_float(w.y & 0xffff0000u)};
                ss += (mv[j][0] * mv[j][0] + mv[j][1] * mv[j][1]) + (mv[j][2] * mv[j][2] + mv[j][3] * mv[j][3]); }
            const float rs = rsqrtf(wave_sum(ss) * (1.0f / DM) + EPSN);
#pragma unroll
            for (int j = 0; j < 4; ++j) { const f32x4 g = *(const f32x4*)(g_res + 4 * lane + 256 * j); v[j] = v[j] + mv[j] * rs * g;
                *(f32x4*)(p.out + (size_t)row * DM + 4 * lane + 256 * j) = v[j]; }
        }
        if (mode != 2) {
            float ss = 0.f;
#pragma unroll
            for (int j = 0; j < 4; ++j) ss += (v[j][0] * v[j][0] + v[j][1] * v[j][1]) + (v[j][2] * v[j][2] + v[j][3] * v[j][3]);
            const float rs = rsqrtf(wave_sum(ss) * (1.0f / DM) + EPSN);
#pragma unroll
            for (int j = 0; j < 4; ++j) { const f32x4 g = *(const f32x4*)(g_h + 4 * lane + 256 * j); const f32x4 h = v[j] * rs * g;
                u32x2 w; w.x = cvt_pk_bf16(h[0], h[1]); w.y = cvt_pk_bf16(h[2], h[3]);
                *(u32x2*)(HB + (size_t)row * DM + 4 * lane + 256 * j) = w; }
        }
    }
}

__device__ __forceinline__ void phase0(const Params& p, unsigned char* lds) {
    const int tid = threadIdx.x, lane = tid & 63, wave = tid >> 6;
    float* scr = (float*)(lds + wave * 8704);
    const int gw = blockIdx.x * 8 + wave, NGW = gridDim.x * 8;
    constexpr int I_SGIN = 16 * 128, I_SGOUT = 32 * 32, I_13 = 16 * 176, I_2 = 44 * 32, I_GLAIN = 16 * 96, I_R = 16, I_GLAOUT = 16 * 32;
    constexpr int NITEMS = I_SGIN + I_SGOUT + 2 * I_13 + 2 * I_2 + I_GLAIN + I_R + I_GLAOUT;
    for (int it = gw; it < NITEMS; it += NGW) {
        int r = it;
        if (r < I_SGIN) { const int kb = r / 128, nb = r % 128; transpose_item(p.sg_w_in, 4096, 4096, (bf16_t*)(p.ws + W_SGIN), 1024, 64 * kb, 32 * nb, 32 * nb, scr, lane); continue; } r -= I_SGIN;
        if (r < I_SGOUT) { const int kb = r / 32, nb = r % 32; transpose_item(p.sg_w_out, 1024, 1024, (bf16_t*)(p.ws + W_SGOUT), 2048, 64 * kb, 32 * nb, 32 * nb, scr, lane); continue; } r -= I_SGOUT;
        if (r < 2 * I_13) { const int l = r / I_13; r -= l * I_13; const int kb = r / 176, nb = r % 176, n0 = 32 * nb;
            const int c0 = ((n0 >> 7) & 1) * DFF + 128 * (n0 >> 8) + (n0 & 127);
            transpose_item(p.ffn_w13 + (size_t)l * 1024 * 5632, 5632, 5632, (bf16_t*)(p.ws + (l ? W_13_1 : W_13_0)), 1024, 64 * kb, c0, n0, scr, lane); continue; } r -= 2 * I_13;
        if (r < 2 * I_2) { const int l = r / I_2; r -= l * I_2; const int kb = r / 32, nb = r % 32;
            transpose_item(p.ffn_w2 + (size_t)l * 2816 * 1024, 1024, 1024, (bf16_t*)(p.ws + (l ? W_2_1 : W_2_0)), 2816, 64 * kb, 32 * nb, 32 * nb, scr, lane); continue; } r -= 2 * I_2;
        if (r < I_GLAIN) { const int kb = r / 96, nb = r % 96; transpose_item(p.gla_w_in, 3088, 3088, (bf16_t*)(p.ws + W_GLAIN), 1024, 64 * kb, 32 * nb, 32 * nb, scr, lane); continue; } r -= I_GLAIN;
        if (r < I_R) { transpose_item(p.gla_w_in, 3088, 3088, (bf16_t*)(p.ws + W_R), 1024, 64 * r, 3072, 0, scr, lane); continue; } r -= I_R;
        { const int kb = r / 32, nb = r % 32; transpose_item(p.gla_w_out, 1024, 1024, (bf16_t*)(p.ws + W_GLAOUT), 1024, 64 * kb, 32 * nb, 32 * nb, scr, lane); }
    }
    { unsigned* hp = (unsigned*)(p.ws + WS_HB + (size_t)MTOT * DM * 2); for (int i = blockIdx.x * 512 + tid; i < (MP - MTOT) * DM / 2; i += gridDim.x * 512) hp[i] = 0u; }
    norm_phase(p, 0, nullptr, p.norm_g, true);
}

__device__ __forceinline__ int vt_h(int vrow) { return ((vrow >> 5) & 1) | (((vrow >> 3) & 1) << 1); }
__device__ __forceinline__ void unpack8(const u32x4 w, float* f) {
    f[0] = __uint_as_float(w.x << 16); f[1] = __uint_as_float(w.x & 0xffff0000u); f[2] = __uint_as_float(w.y << 16); f[3] = __uint_as_float(w.y & 0xffff0000u);
    f[4] = __uint_as_float(w.z << 16); f[5] = __uint_as_float(w.z & 0xffff0000u); f[6] = __uint_as_float(w.w << 16); f[7] = __uint_as_float(w.w & 0xffff0000u);
}
__device__ __forceinline__ void sgu_phase(const Params& p, unsigned char* lds) {
    const int tid = threadIdx.x, lane = tid & 63, wave = tid >> 6, fr = lane & 15, fq = lane >> 4;
    bf16_t* UB = (bf16_t*)(p.ws + WS_R1); const bf16_t* VB = (const bf16_t*)(p.ws + WS_R1 + (size_t)MP * 2048 * 2); const float* stats = (const float*)(p.ws + WS_STATS);
    for (int task = blockIdx.x * 512 + tid; task < MSM * 256; task += gridDim.x * 512) {
        const int r = task >> 8, col = (task & 255) * 8, g = col >> 8, row = MPR + r;
        float ssum = 0.f, sq = 0.f;
#pragma unroll
        for (int i = 0; i < 16; ++i) { const f32x4 t4 = *(const f32x4*)(stats + (size_t)row * 64 + 4 * i); ssum += t4[0] + t4[2]; sq += t4[1] + t4[3]; }
        const float mean = ssum * (1.0f / SGW), var = sq * (1.0f / SGW) - mean * mean, rstd = rsqrtf(fmaxf(var, 0.f) + EPSN);
        float vv[8], uu[8]; unpack8(*(const u32x4*)(VB + (size_t)row * SGW + col), vv); unpack8(*(const u32x4*)(UB + (size_t)row * SGW + col), uu);
        const float w00 = p.sg_w_s[(size_t)g * 128 * 128], b0 = p.sg_b_s[g * 128];
        float vn[8], ga[8];
#pragma unroll
        for (int i = 0; i < 8; ++i) { vn[i] = (vv[i] - mean) * rstd * p.sg_ln_g[col + i] + p.sg_ln_b[col + i]; ga[i] = uu[i] * (w00 * vn[i] + b0); }
        float* so = p.out + O_SGVS + (size_t)r * SGW + col;
        *(f32x4*)so = (f32x4){vn[0], vn[1], vn[2], vn[3]}; *(f32x4*)(so + 4) = (f32x4){vn[4], vn[5], vn[6], vn[7]};
        u32x4 w; w.x = cvt_pk_bf16(ga[0], ga[1]); w.y = cvt_pk_bf16(ga[2], ga[3]); w.z = cvt_pk_bf16(ga[4], ga[5]); w.w = cvt_pk_bf16(ga[6], ga[7]);
        *(u32x4*)(UB + (size_t)row * SGW + col) = w;
    }
    unsigned char* WL = lds; unsigned char* VT = lds + 34816; pg8::f32x2* MR = (pg8::f32x2*)(lds + 104448);
    int staged_g = -1;
    const int wr = wave >> 2, wc = wave & 3;
    for (int unit = blockIdx.x; unit < 1024; unit += gridDim.x) {
        const int g = unit & 7, chunk = unit >> 3, r0 = chunk * 128, c0 = g * 256;
        __syncthreads();
        if (g != staged_g) { staged_g = g;
#pragma unroll
            for (int it = 0; it < 4; ++it) { const int idx = it * 512 + tid, t = idx >> 4, s0 = (idx & 15) * 8;
                const float* src = p.sg_w_s + ((size_t)g * 128 + t) * 128 + s0; const f32x4 a = *(const f32x4*)src, b = *(const f32x4*)(src + 4);
                float f[8] = {a[0], a[1], a[2], a[3], b[0], b[1], b[2], b[3]};
#pragma unroll
                for (int i = 0; i < 8; ++i) f[i] = (s0 + i <= t) ? f[i] : 0.f;
                u32x4 w; w.x = cvt_pk_bf16(f[0], f[1]); w.y = cvt_pk_bf16(f[2], f[3]); w.z = cvt_pk_bf16(f[4], f[5]); w.w = cvt_pk_bf16(f[6], f[7]);
                *(u32x4*)(WL + t * 272 + s0 * 2) = w; } }
        { const int rl = tid >> 2, part = tid & 3; float ssum = 0.f, sq = 0.f;
#pragma unroll
          for (int i = 0; i < 4; ++i) { const f32x4 t4 = *(const f32x4*)(stats + (size_t)(r0 + rl) * 64 + 16 * part + 4 * i); ssum += t4[0] + t4[2]; sq += t4[1] + t4[3]; }
          ssum += __shfl_xor(ssum, 1); sq += __shfl_xor(sq, 1); ssum += __shfl_xor(ssum, 2); sq += __shfl_xor(sq, 2);
          const float mean = ssum * (1.0f / SGW), rstd = rsqrtf(fmaxf(sq * (1.0f / SGW) - mean * mean, 0.f) + EPSN);
          if (part == 0) MR[rl] = (pg8::f32x2){mean, rstd}; }
        __syncthreads();
        const bool lastc = (chunk & 15) == 15; const int bb = chunk >> 4;
#pragma unroll
        for (int it = 0; it < 4; ++it) {
            const int block = it * 8 + wave, colblk = block & 3, tokblk = block >> 2, cgp = lane & 7, spl = (lane >> 3) & 3, chl = lane >> 5;
            const int s = 16 * tokblk + 8 * chl + 2 * spl, colL = 64 * colblk + 8 * cgp, rowA = r0 + s;
            float va[8], vb[8]; unpack8(*(const u32x4*)(VB + (size_t)rowA * SGW + c0 + colL), va); unpack8(*(const u32x4*)(VB + (size_t)(rowA + 1) * SGW + c0 + colL), vb);
            const f32x4 st = *(const f32x4*)(MR + s);
            const float meanA = st[0], rstdA = st[1], meanB = st[2], rstdB = st[3];
            const f32x4 g0 = *(const f32x4*)(p.sg_ln_g + c0 + colL), g1 = *(const f32x4*)(p.sg_ln_g + c0 + colL + 4), b0 = *(const f32x4*)(p.sg_ln_b + c0 + colL), b1 = *(const f32x4*)(p.sg_ln_b + c0 + colL + 4);
            const float gg[8] = {g0[0], g0[1], g0[2], g0[3], g1[0], g1[1], g1[2], g1[3]}, bbv[8] = {b0[0], b0[1], b0[2], b0[3], b1[0], b1[1], b1[2], b1[3]};
#pragma unroll
            for (int i = 0; i < 8; ++i) { va[i] = (va[i] - meanA) * rstdA * gg[i] + bbv[i]; vb[i] = (vb[i] - meanB) * rstdB * gg[i] + bbv[i]; }
            if (lastc) { float* so = p.out + O_SGVP + ((size_t)(bb * 128 + s)) * SGW + c0 + colL;
                *(f32x4*)so = (f32x4){va[0], va[1], va[2], va[3]}; *(f32x4*)(so + 4) = (f32x4){va[4], va[5], va[6], va[7]};
                *(f32x4*)(so + SGW) = (f32x4){vb[0], vb[1], vb[2], vb[3]}; *(f32x4*)(so + SGW + 4) = (f32x4){vb[4], vb[5], vb[6], vb[7]}; }
#pragma unroll
            for (int i = 0; i < 8; ++i) { const int c = colL + i; const int vrow = (c & ~63) | (((c >> 2) & 3) << 4) | (((c >> 4) & 3) << 2) | (c & 3);
                const int pch = (s >> 3) ^ vt_h(vrow);
                *(unsigned*)(VT + vrow * 272 + (pch * 8 + (s & 7)) * 2) = cvt_pk_bf16(va[i], vb[i]); }
        }
        __syncthreads();
        f32x4 acc[4][4];
#pragma unroll
        for (int a = 0; a < 4; ++a)
#pragma unroll
            for (int b = 0; b < 4; ++b) acc[a][b] = (f32x4){0.f, 0.f, 0.f, 0.f};
#pragma unroll
        for (int ks = 0; ks < 4; ++ks) {
            if (32 * ks <= 64 * wr + 63) {
                bf16x8 bfr[4];
#pragma unroll
                for (int ni = 0; ni < 4; ++ni) { const int vrow = 64 * wc + 16 * ni + fr; bfr[ni] = *(const bf16x8*)(VT + vrow * 272 + (((4 * ks + fq) ^ vt_h(vrow)) * 16)); }
#pragma unroll
                for (int mi = 0; mi < 4; ++mi) {
                    if (32 * ks <= 64 * wr + 16 * mi + 15) {
                        const bf16x8 af = *(const bf16x8*)(WL + (64 * wr + 16 * mi + fr) * 272 + (32 * ks + 8 * fq) * 2);
#pragma unroll
                        for (int ni = 0; ni < 4; ++ni) acc[mi][ni] = __builtin_amdgcn_mfma_f32_16x16x32_bf16(bfr[ni], af, acc[mi][ni], 0, 0, 0);
                    } } } }
#pragma unroll
        for (int mi = 0; mi < 4; ++mi) {
            const int t = 64 * wr + 16 * mi + fr; const float bias = p.sg_b_s[g * 128 + t];
            bf16_t* up = UB + (size_t)(r0 + t) * SGW + c0 + 64 * wc + 16 * fq;
            float u0[8], u1[8]; unpack8(*(const u32x4*)up, u0); unpack8(*(const u32x4*)(up + 8), u1);
            u32x4 w0, w1;
            w0.x = cvt_pk_bf16(u0[0] * (acc[mi][0][0] + bias), u0[1] * (acc[mi][0][1] + bias)); w0.y = cvt_pk_bf16(u0[2] * (acc[mi][0][2] + bias), u0[3] * (acc[mi][0][3] + bias));
            w0.z = cvt_pk_bf16(u0[4] * (acc[mi][1][0] + bias), u0[5] * (acc[mi][1][1] + bias)); w0.w = cvt_pk_bf16(u0[6] * (acc[mi][1][2] + bias), u0[7] * (acc[mi][1][3] + bias));
            w1.x = cvt_pk_bf16(u1[0] * (acc[mi][2][0] + bias), u1[1] * (acc[mi][2][1] + bias)); w1.y = cvt_pk_bf16(u1[2] * (acc[mi][2][2] + bias), u1[3] * (acc[mi][2][3] + bias));
            w1.z = cvt_pk_bf16(u1[4] * (acc[mi][3][0] + bias), u1[5] * (acc[mi][3][1] + bias)); w1.w = cvt_pk_bf16(u1[6] * (acc[mi][3][2] + bias), u1[7] * (acc[mi][3][3] + bias));
            *(u32x4*)up = w0; *(u32x4*)(up + 8) = w1;
        }
    }
}

__device__ __forceinline__ void gla_r_tasks(const Params& p) {
    const int lane = threadIdx.x & 63, wave = threadIdx.x >> 6, fr = lane & 15, fq = lane >> 4;
    const bf16_t* HB = (const bf16_t*)(p.ws + WS_HB); const bf16_t* WR = (const bf16_t*)(p.ws + W_R); float* RB = (float*)(p.ws + WS_RBUF);
    for (int task = blockIdx.x * 8 + wave; task < MTOT / 16; task += gridDim.x * 8) {
        const int row0 = task * 16; f32x4 acc = (f32x4){0.f, 0.f, 0.f, 0.f};
#pragma unroll 8
        for (int ks = 0; ks < 32; ++ks) {
            const bf16x8 a = *(const bf16x8*)(WR + (size_t)fr * DM + 32 * ks + 8 * fq), b = *(const bf16x8*)(HB + (size_t)(row0 + fr) * DM + 32 * ks + 8 * fq);
            acc = __builtin_amdgcn_mfma_f32_16x16x32_bf16(a, b, acc, 0, 0, 0); }
        *(f32x4*)(RB + (size_t)(row0 + fr) * 16 + 4 * fq) = acc;
    }
}
__device__ __forceinline__ float logsig16(float x) { return (fminf(x, 0.f) - __logf(1.0f + __expf(-fabsf(x)))) * (1.0f / 16.0f); }

__device__ __forceinline__ void gla_prep_phase(const Params& p, unsigned char* lds) {
    const int tid = threadIdx.x, lane = tid & 63, wave = tid >> 6, fr = lane & 15, fq = lane >> 4;
    const bf16_t* QKVG = (const bf16_t*)(p.ws + WS_R1); const float* RB = (const float*)(p.ws + WS_RBUF);
    bf16_t* QBg = (bf16_t*)(p.ws + WS_QB); bf16_t* ATTg = (bf16_t*)(p.ws + WS_ATT); bf16_t* KDTg = (bf16_t*)(p.ws + WS_KDT); bf16_t* VTg = (bf16_t*)(p.ws + WS_MBUF);
    float* DL = (float*)(p.ws + WS_DLAST); bf16_t* OB = (bf16_t*)(p.ws + WS_HB);
    float* RL = (float*)lds;
    float* TOT = (float*)(lds + 4096);
    unsigned char* QL = lds + 6144;
    unsigned char* KL = lds + 6144 + 17408;
    unsigned char* VL = lds + 6144 + 2 * 17408;
    const float scale = 0.08838834764831845f;
    for (int u = blockIdx.x; u < 1024; u += gridDim.x) {
        const int c = u & 31, h = (u >> 5) & 3, b = u >> 7, row0 = b * SEQ + 64 * c;
        __syncthreads();
        if (tid < 256) *(f32x4*)(RL + 4 * tid) = *(const f32x4*)(RB + (size_t)row0 * 16 + 4 * tid);
        { const int s = tid >> 3, seg = tid & 7;
#pragma unroll
          for (int i = 0; i < 4; ++i) *(u32x4*)(VL + s * 528 + (32 * seg + 8 * i) * 2) = *(const u32x4*)(QKVG + (size_t)(row0 + s) * 3072 + 1024 + 256 * h + 32 * seg + 8 * i); }
        const int kc = tid & 127, tq = tid >> 7;
        float wg[16];
#pragma unroll
        for (int j = 0; j < 16; ++j) wg[j] = p.gla_w_gate_up[j * 512 + 128 * h + kc];
        const float bg = p.gla_b_gate[128 * h + kc];
        __syncthreads();
        float cum[16]; float run = 0.f;
#pragma unroll
        for (int i = 0; i < 16; ++i) { const float* rr = RL + (16 * tq + i) * 16; float x = bg;
#pragma unroll
            for (int j = 0; j < 16; ++j) x += rr[j] * wg[j];
            run += logsig16(x); cum[i] = run; }
        TOT[tq * 128 + kc] = run;
        __syncthreads();
        float off = 0.f, blast = 0.f;
#pragma unroll
        for (int q = 0; q < 4; ++q) { const float tv = TOT[q * 128 + kc]; blast += tv; off += (q < tq) ? tv : 0.f; }
        unsigned kdp[8];
#pragma unroll
        for (int i = 0; i < 16; i += 2) {
            float kd2[2];
#pragma unroll
            for (int e = 0; e < 2; ++e) { const int t = 16 * tq + i + e; const float bbv = off + cum[i + e];
                const float qv = bf2f(QKVG[(size_t)(row0 + t) * 3072 + 128 * h + kc]), kv = bf2f(QKVG[(size_t)(row0 + t) * 3072 + 512 + 128 * h + kc]);
                const float qb = qv * scale * __expf(bbv), kb = kv * __expf(-bbv); kd2[e] = kv * __expf(blast - bbv);
                const unsigned short qh = (unsigned short)(cvt_pk_bf16(qb, 0.f) & 0xffffu), kh = (unsigned short)(cvt_pk_bf16(kb, 0.f) & 0xffffu);
                *(unsigned short*)(QL + t * 272 + kc * 2) = qh; *(unsigned short*)(KL + t * 272 + kc * 2) = kh;
                QBg[(size_t)(row0 + t) * 512 + 128 * h + kc] = qh; }
            kdp[i >> 1] = cvt_pk_bf16(kd2[0], kd2[1]); }
        { bf16_t* kp = KDTg + ((size_t)u * 128 + kc) * 64 + 16 * tq;
          *(u32x4*)kp = (u32x4){kdp[0], kdp[1], kdp[2], kdp[3]}; *(u32x4*)(kp + 8) = (u32x4){kdp[4], kdp[5], kdp[6], kdp[7]}; }
        if (tq == 0) DL[u * 128 + kc] = __expf(blast);
        __syncthreads();
        { const int tb = wave >> 1;
#pragma unroll
          for (int e = 0; e < 2; ++e) { const int sb = 2 * (wave & 1) + e; f32x4 acc = (f32x4){0.f, 0.f, 0.f, 0.f};
              if (sb <= tb) {
#pragma unroll
                  for (int ks = 0; ks < 4; ++ks) { const bf16x8 a = *(const bf16x8*)(KL + (16 * sb + fr) * 272 + (32 * ks + 8 * fq) * 2), bq = *(const bf16x8*)(QL + (16 * tb + fr) * 272 + (32 * ks + 8 * fq) * 2);
                      acc = __builtin_amdgcn_mfma_f32_16x16x32_bf16(a, bq, acc, 0, 0, 0); } }
              const int t = 16 * tb + fr, s0 = 16 * sb + 4 * fq;
              u32x2 w; w.x = cvt_pk_bf16(s0 + 0 <= t ? acc[0] : 0.f, s0 + 1 <= t ? acc[1] : 0.f); w.y = cvt_pk_bf16(s0 + 2 <= t ? acc[2] : 0.f, s0 + 3 <= t ? acc[3] : 0.f);
              *(u32x2*)(ATTg + ((size_t)u * 64 + t) * 64 + s0) = w; } }
        { const int j = tid >> 1, half = tid & 1; unsigned w[16];
#pragma unroll
          for (int i = 0; i < 16; ++i) { const unsigned lo = *(const unsigned short*)(VL + (32 * half + 2 * i) * 528 + j * 2), hi = *(const unsigned short*)(VL + (32 * half + 2 * i + 1) * 528 + j * 2); w[i] = lo | (hi << 16); }
          bf16_t* vp = VTg + ((size_t)u * 256 + j) * 64 + 32 * half;
#pragma unroll
          for (int i = 0; i < 4; ++i) *(u32x4*)(vp + 8 * i) = (u32x4){w[4 * i], w[4 * i + 1], w[4 * i + 2], w[4 * i + 3]}; }
    }
    float* AL = (float*)lds; float* QS = AL + 128; float* KS = QS + 128; float* OP = KS + 128;
    for (int u = blockIdx.x; u < MSM * 4; u += gridDim.x) {
        const int b = u >> 2, h = u & 3, row = MPR + b;
        __syncthreads();
        if (tid < 128) { float x = p.gla_b_gate[128 * h + tid];
#pragma unroll
            for (int j = 0; j < 16; ++j) x += RB[(size_t)row * 16 + j] * p.gla_w_gate_up[j * 512 + 128 * h + tid];
            AL[tid] = __expf(logsig16(x)); QS[tid] = bf2f(QKVG[(size_t)row * 3072 + 128 * h + tid]) * scale; KS[tid] = bf2f(QKVG[(size_t)row * 3072 + 512 + 128 * h + tid]); }
        const int j4 = (tid & 63) * 4, kq = tid >> 6;
        const u32x2 vw = *(const u32x2*)(QKVG + (size_t)row * 3072 + 1024 + 256 * h + j4);
        const f32x4 vv = (f32x4){__uint_as_float(vw.x << 16), __uint_as_float(vw.x & 0xffff0000u), __uint_as_float(vw.y << 16), __uint_as_float(vw.y & 0xffff0000u)};
        __syncthreads();
        f32x4 oacc = (f32x4){0.f, 0.f, 0.f, 0.f};
        const size_t sbase = ((size_t)(b * 4 + h) * 128) * 256 + j4;
#pragma unroll 4
        for (int i = 0; i < 16; ++i) { const int kcc = 16 * kq + i; const f32x4 s0 = *(const f32x4*)(p.state_gla + sbase + (size_t)kcc * 256);
            const f32x4 sn = s0 * AL[kcc] + vv * KS[kcc]; *(f32x4*)(p.out + O_STS + sbase + (size_t)kcc * 256) = sn; oacc = oacc + sn * QS[kcc]; }
        *(f32x4*)(OP + kq * 256 + j4) = oacc;
        __syncthreads();
        if (tid < 256) { float o = 0.f;
#pragma unroll
            for (int q = 0; q < 8; ++q) o += OP[q * 256 + tid];
            OB[(size_t)row * DM + 256 * h + tid] = (unsigned short)(cvt_pk_bf16(o, 0.f) & 0xffffu); }
    }
}

struct ScanFrags { bf16x8 qf[4], af[2], kdf[2], vf[2][2]; f32x4 dl; };
__device__ __forceinline__ void scan_load(ScanFrags& F, const Params& p, int pu, int row0, int h, int vs, int tb, int kcb, int fr, int fq) {
    const bf16_t* QBg = (const bf16_t*)(p.ws + WS_QB); const bf16_t* ATTg = (const bf16_t*)(p.ws + WS_ATT); const bf16_t* KDTg = (const bf16_t*)(p.ws + WS_KDT); const bf16_t* VTg = (const bf16_t*)(p.ws + WS_MBUF);
    const float* DL = (const float*)(p.ws + WS_DLAST);
#pragma unroll
    for (int ks = 0; ks < 4; ++ks) F.qf[ks] = *(const bf16x8*)(QBg + (size_t)(row0 + 16 * tb + fr) * 512 + 128 * h + 32 * ks + 8 * fq);
#pragma unroll
    for (int ks = 0; ks < 2; ++ks) { F.af[ks] = *(const bf16x8*)(ATTg + ((size_t)pu * 64 + 16 * tb + fr) * 64 + 32 * ks + 8 * fq);
        F.kdf[ks] = *(const bf16x8*)(KDTg + ((size_t)pu * 128 + 16 * kcb + fr) * 64 + 32 * ks + 8 * fq);
#pragma unroll
        for (int jb = 0; jb < 2; ++jb) F.vf[jb][ks] = *(const bf16x8*)(VTg + ((size_t)pu * 256 + 32 * vs + 16 * jb + fr) * 64 + 32 * ks + 8 * fq); }
    F.dl = *(const f32x4*)(DL + pu * 128 + 16 * kcb + 4 * fq);
}
__device__ __forceinline__ void gla_scan_phase(const Params& p, unsigned char* lds) {
    const int tid = threadIdx.x, lane = tid & 63, wave = tid >> 6, fr = lane & 15, fq = lane >> 4;
    bf16_t* OB = (bf16_t*)(p.ws + WS_HB);
    unsigned char* ST = lds;
    const int tb = wave >> 1, jbo = wave & 1, kcb = wave;
    for (int u = blockIdx.x; u < 256; u += gridDim.x) {
        const int vs = u & 7, h = (u >> 3) & 3, b = u >> 5;
        __syncthreads();
        for (int i = tid; i < 32 * 272 / 4; i += 512) ((unsigned*)ST)[i] = 0u;
        f32x4 accS[2] = {(f32x4){0.f, 0.f, 0.f, 0.f}, (f32x4){0.f, 0.f, 0.f, 0.f}};
        ScanFrags cur; scan_load(cur, p, (b * 4 + h) * 32, b * SEQ, h, vs, tb, kcb, fr, fq);
        __syncthreads();
        for (int c = 0; c < 32; ++c) {
            const int row0 = b * SEQ + 64 * c;
            ScanFrags nxt; { const int cn = c < 31 ? c + 1 : 31; scan_load(nxt, p, (b * 4 + h) * 32 + cn, b * SEQ + 64 * cn, h, vs, tb, kcb, fr, fq); }
            f32x4 acco = (f32x4){0.f, 0.f, 0.f, 0.f};
#pragma unroll
            for (int ks = 0; ks < 4; ++ks) { const bf16x8 stf = *(const bf16x8*)(ST + (16 * jbo + fr) * 272 + (32 * ks + 8 * fq) * 2);
                acco = __builtin_amdgcn_mfma_f32_16x16x32_bf16(stf, cur.qf[ks], acco, 0, 0, 0); }
#pragma unroll
            for (int ks = 0; ks < 2; ++ks) if (2 * ks <= tb) acco = __builtin_amdgcn_mfma_f32_16x16x32_bf16(jbo ? cur.vf[1][ks] : cur.vf[0][ks], cur.af[ks], acco, 0, 0, 0);
            { u32x2 w; w.x = cvt_pk_bf16(acco[0], acco[1]); w.y = cvt_pk_bf16(acco[2], acco[3]);
              *(u32x2*)(OB + (size_t)(row0 + 16 * tb + fr) * DM + 256 * h + 32 * vs + 16 * jbo + 4 * fq) = w; }
            __syncthreads();
#pragma unroll
            for (int jb = 0; jb < 2; ++jb) { accS[jb] = accS[jb] * cur.dl;
#pragma unroll
                for (int ks = 0; ks < 2; ++ks) accS[jb] = __builtin_amdgcn_mfma_f32_16x16x32_bf16(cur.kdf[ks], cur.vf[jb][ks], accS[jb], 0, 0, 0);
                u32x2 w; w.x = cvt_pk_bf16(accS[jb][0], accS[jb][1]); w.y = cvt_pk_bf16(accS[jb][2], accS[jb][3]);
                *(u32x2*)(ST + (16 * jb + fr) * 272 + (16 * kcb + 4 * fq) * 2) = w; }
            __syncthreads();
            cur = nxt;
        }
#pragma unroll
        for (int jb = 0; jb < 2; ++jb)
#pragma unroll
            for (int i = 0; i < 4; ++i) p.out[O_STP + ((size_t)(b * 4 + h) * 128 + 16 * kcb + 4 * fq + i) * 256 + 32 * vs + 16 * jb + fr] = accS[jb][i];
    }
}

__device__ __forceinline__ void gla_gate_phase(const Params& p) {
    const int lane = threadIdx.x & 63, wave = threadIdx.x >> 6;
    bf16_t* OB = (bf16_t*)(p.ws + WS_HB); const bf16_t* QKVG = (const bf16_t*)(p.ws + WS_R1);
    const f32x4 gn = *(const f32x4*)(p.gla_out_norm_g + 4 * lane);
    for (int row = blockIdx.x * 8 + wave; row < MTOT; row += gridDim.x * 8) {
#pragma unroll
        for (int j = 0; j < 4; ++j) {
            const u32x2 ow = *(const u32x2*)(OB + (size_t)row * DM + 256 * j + 4 * lane), gw = *(const u32x2*)(QKVG + (size_t)row * 3072 + 2048 + 256 * j + 4 * lane);
            const f32x4 o = (f32x4){__uint_as_float(ow.x << 16), __uint_as_float(ow.x & 0xffff0000u), __uint_as_float(ow.y << 16), __uint_as_float(ow.y & 0xffff0000u)};
            const f32x4 g = (f32x4){__uint_as_float(gw.x << 16), __uint_as_float(gw.x & 0xffff0000u), __uint_as_float(gw.y << 16), __uint_as_float(gw.y & 0xffff0000u)};
            const float rs = rsqrtf(wave_sum((o[0] * o[0] + o[1] * o[1]) + (o[2] * o[2] + o[3] * o[3])) * (1.0f / 256.0f) + EPSN);
            u32x2 w; w.x = cvt_pk_bf16(o[0] * rs * gn[0] * silu_f(g[0]), o[1] * rs * gn[1] * silu_f(g[1])); w.y = cvt_pk_bf16(o[2] * rs * gn[2] * silu_f(g[2]), o[3] * rs * gn[3] * silu_f(g[3]));
            *(u32x2*)(OB + (size_t)row * DM + 256 * j + 4 * lane) = w;
        }
    }
}

__device__ __forceinline__ void gsync(cg::grid_group& g) {
    asm volatile("s_waitcnt vmcnt(0) lgkmcnt(0)" ::: "memory");
    g.sync();
    __builtin_amdgcn_fence(__ATOMIC_ACQUIRE, "agent");
    asm volatile("s_waitcnt vmcnt(0)" ::: "memory");
}
template <class Epi> __device__ __forceinline__ void run_gemm(unsigned char* lds, const bf16_t* A, const bf16_t* Bt, int N, int K, const Epi& E) {
    pg8::Gemm g; g.A = A; g.Bt = Bt; g.M = MP; g.N = N; g.K = K;
    pg8::StaticOrder S; S.init(MP, N, (int)gridDim.x, (int)blockIdx.x);
    pg8::gemm_phase<Epi, pg8::StaticOrder, false>((PG8_LAS unsigned char*)lds, g, S, E, nullptr);
}

__global__ void __launch_bounds__(512, 2) fwd_megakernel(Params p) {
    extern __shared__ __attribute__((aligned(16))) unsigned char shm[];
    cg::grid_group grid = cg::this_grid();
    unsigned char* ws = p.ws;
    bf16_t* HB = (bf16_t*)(ws + WS_HB); bf16_t* UB = (bf16_t*)(ws + WS_R1); bf16_t* VB = UB + (size_t)MP * 2048; bf16_t* MB = (bf16_t*)(ws + WS_MBUF);
    bf16_t* ACT = (bf16_t*)(ws + WS_R1); bf16_t* QKVG = (bf16_t*)(ws + WS_R1);
    const float* ng = p.norm_g;
    phase0(p, shm);
    gsync(grid);
    { pg8::EpiSgIn E; E.U = UB; E.V = VB; E.stats = (float*)(ws + WS_STATS); run_gemm(shm, HB, (const bf16_t*)(ws + W_SGIN), 4096, 1024, E); }
    gsync(grid);
    sgu_phase(p, shm);
    gsync(grid);
    { pg8::EpiStoreBf16 E; E.O = MB; E.ldc = 1024; run_gemm(shm, UB, (const bf16_t*)(ws + W_SGOUT), 1024, 2048, E); }
    gsync(grid);
    norm_phase(p, 1, ng + 1 * DM, ng + 2 * DM, true);
    gsync(grid);
    { pg8::EpiSwiglu E; E.O = ACT; run_gemm(shm, HB, (const bf16_t*)(ws + W_13_0), 5632, 1024, E); }
    gsync(grid);
    { pg8::EpiStoreBf16 E; E.O = MB; E.ldc = 1024; run_gemm(shm, ACT, (const bf16_t*)(ws + W_2_0), 1024, 2816, E); }
    gsync(grid);
    norm_phase(p, 1, ng + 3 * DM, ng + 4 * DM, false);
    gsync(grid);
    { pg8::EpiStoreBf16 E; E.O = QKVG; E.ldc = 3072; run_gemm(shm, HB, (const bf16_t*)(ws + W_GLAIN), 3072, 1024, E); }
    gla_r_tasks(p);
    gsync(grid);
    gla_prep_phase(p, shm);
    gsync(grid);
    gla_scan_phase(p, shm);
    gsync(grid);
    gla_gate_phase(p);
    gsync(grid);
    { pg8::EpiStoreBf16 E; E.O = MB; E.ldc = 1024; run_gemm(shm, HB, (const bf16_t*)(ws + W_GLAOUT), 1024, 1024, E); }
    gsync(grid);
    norm_phase(p, 1, ng + 5 * DM, ng + 6 * DM, false);
    gsync(grid);
    { pg8::EpiSwiglu E; E.O = ACT; run_gemm(shm, HB, (const bf16_t*)(ws + W_13_1), 5632, 1024, E); }
    gsync(grid);
    { pg8::EpiStoreBf16 E; E.O = MB; E.ldc = 1024; run_gemm(shm, ACT, (const bf16_t*)(ws + W_2_1), 1024, 2816, E); }
    gsync(grid);
    norm_phase(p, 2, ng + 7 * DM, nullptr, false);
}

extern "C" void kernel_launch(void* const* d_in, const int* in_sizes, int n_in, void* d_out, int out_size, void* d_ws, size_t ws_size, hipStream_t stream) {
    static int grid_blocks = 0;
    if (!grid_blocks) {
        if (n_in != 17 || ws_size < WS_END) { fprintf(stderr, "kernel_launch: unexpected n_in %d or ws_size %zu (< %zu)\n", n_in, ws_size, (size_t)WS_END); grid_blocks = -1; return; }
        int dev = 0, cus = 0, per_cu = 0;
        hipGetDevice(&dev);
        hipDeviceGetAttribute(&cus, hipDeviceAttributeMultiprocessorCount, dev);
        hipFuncSetAttribute((const void*)fwd_megakernel, hipFuncAttributeMaxDynamicSharedMemorySize, LDS_BYTES);
        hipOccupancyMaxActiveBlocksPerMultiprocessor(&per_cu, (const void*)fwd_megakernel, 512, LDS_BYTES);
        if (per_cu < 1) { fprintf(stderr, "kernel_launch: occupancy query returned %d\n", per_cu); per_cu = 1; }
        grid_blocks = cus * per_cu;
    }
    if (grid_blocks < 0) return;
    Params p{};
    p.x_prompt = (const float*)d_in[0]; p.x_sample = (const float*)d_in[1]; p.state_gla = (const float*)d_in[2]; p.norm_g = (const float*)d_in[3];
    p.ffn_w13 = (const float*)d_in[4]; p.ffn_w2 = (const float*)d_in[5]; p.sg_w_in = (const float*)d_in[6]; p.sg_ln_g = (const float*)d_in[7]; p.sg_ln_b = (const float*)d_in[8];
    p.sg_w_s = (const float*)d_in[9]; p.sg_b_s = (const float*)d_in[10]; p.sg_w_out = (const float*)d_in[11]; p.gla_w_in = (const float*)d_in[12];
    p.gla_w_gate_up = (const float*)d_in[13]; p.gla_b_gate = (const float*)d_in[14]; p.gla_out_norm_g = (const float*)d_in[15]; p.gla_w_out = (const float*)d_in[16];
    p.out = (float*)d_out; p.ws = (unsigned char*)d_ws;
    void* args[] = {&p};
    hipError_t e = hipLaunchCooperativeKernel((const void*)fwd_megakernel, dim3(grid_blocks), dim3(512), args, LDS_BYTES, stream);
    if (e != hipSuccess) fprintf(stderr, "cooperative launch failed: %s (grid %d)\n", hipGetErrorString(e), grid_blocks);
}
```

```cpp
#include <hip/hip_runtime.h>
#include <hip/hip_cooperative_groups.h>
#include <cstdio>
namespace cg = cooperative_groups;
__device__ __forceinline__ int tidx() { int t = (int)threadIdx.x; asm volatile("" : "+v"(t)); return t; }

namespace pg8 {
#define PG8_LAS __attribute__((address_space(3)))
typedef unsigned short bf16_t;
typedef short bf16x8 __attribute__((ext_vector_type(8)));
typedef float f32x4 __attribute__((ext_vector_type(4)));
typedef unsigned u32x4 __attribute__((ext_vector_type(4)));
constexpr int BM = 256, BK = 64, HALF = 128, HTB = HALF * BK * 2  , STAGE_BYTES = 8 * HTB, NXCD = 8, WGM = 8;

__host__ __device__ __forceinline__ int lds_byte(int r, int c) { const int st = (r >> 4) * 2 + (c >> 5), rr = r & 15, cc = c & 31, ob = rr * 64 + cc * 2; return st * 1024 + (ob ^ (((ob >> 9) & 1) << 5)); }
__host__ __device__ __forceinline__ void stage_rc(int b, int& R, int& C) { const int st = b / 1024, sb = b % 1024, swz = sb ^ (((sb >> 9) & 1) << 5); R = (st >> 1) * 16 + swz / 64; C = (st & 1) * 32 + (swz % 64) / 2; }
__host__ __device__ __forceinline__ int perm32(int rho) { const int n = rho >> 4, i = rho & 15; return 8 * (i >> 2) + 4 * n + (i & 3); }

struct Unit { int pm, pn; };
struct Gemm { const bf16_t* A; const bf16_t* Bt; int M, N, K; };

struct StaticOrder {
    int nM, nN, nwg, G, c;
    __host__ __device__ void init(int M, int N, int G_, int c_) { nM = M / BM; nN = N / BM; nwg = nM * nN; G = G_; c = c_; }
    __host__ __device__ bool next(int i, Unit& u) const {
        const long L = (long)i * G + c; if (L >= nwg) return false;
        int wgid = (int)L; { const int q = nwg / NXCD, r = nwg % NXCD, xcd = wgid % NXCD, off = wgid / NXCD; wgid = (xcd < r ? xcd * (q + 1) : r * (q + 1) + (xcd - r) * q) + off; }
        const int nig = WGM * nN, gid = wgid / nig, fm = gid * WGM, gsz = (nM - fm) < WGM ? (nM - fm) : WGM;
        u.pm = fm + ((wgid % nig) % gsz); u.pn = (wgid % nig) / gsz; return true;
    }
    __device__ __forceinline__ void a_ready(const Unit&) const {}
    __device__ __forceinline__ void done(const Unit&) const {}
};
typedef __bf16 bf16x2v_t __attribute__((ext_vector_type(2)));
__device__ __forceinline__ unsigned cvt_pk_bf16(float lo, float hi) { typedef float f2_t __attribute__((ext_vector_type(2))); const f2_t v = {lo, hi}; const bf16x2v_t r = __builtin_convertvector(v, bf16x2v_t); return __builtin_bit_cast(unsigned, r); }
typedef float f32x2 __attribute__((ext_vector_type(2)));
__device__ __forceinline__ f32x2 gelu_pk(f32x2 v) {
    const f32x2 av = __builtin_elementwise_abs(v), d = av * 0.2316418882f + 1.0f;
    f32x2 t; t.x = __builtin_amdgcn_rcpf(d.x); t.y = __builtin_amdgcn_rcpf(d.y);
    f32x2 q = t * 0.5307027145f + (-0.7265760135f); q = q * t + 0.7107068705f; q = q * t + (-0.142248368f); q = q * t + 0.127414796f; q = q * t;
    const f32x2 s = (v * v) * (-0.72134752044f);
    f32x2 e; e.x = __builtin_amdgcn_exp2f(s.x); e.y = __builtin_amdgcn_exp2f(s.y);
    const f32x2 m = v * (q * e), r = v - m;
    f32x2 o; o.x = v.x < 0.f ? m.x : r.x; o.y = v.y < 0.f ? m.y : r.y; return o;
}
typedef unsigned long long u64_t;
__device__ __forceinline__ u32x4 quad_rows(const u32x4 w, int lane) {
    const int src = ((lane >> 2) + 16 * (lane & 3)) * 4; u32x4 r;
    r.x = (unsigned)__builtin_amdgcn_ds_bpermute(src, (int)w.x); r.y = (unsigned)__builtin_amdgcn_ds_bpermute(src, (int)w.y);
    r.z = (unsigned)__builtin_amdgcn_ds_bpermute(src, (int)w.z); r.w = (unsigned)__builtin_amdgcn_ds_bpermute(src, (int)w.w); return r; }
__device__ __forceinline__ float bf2f(unsigned short b) { return __uint_as_float(((unsigned)b) << 16); }
__device__ __forceinline__ float silu_f(float x) { return x * __builtin_amdgcn_rcpf(1.0f + __expf(-x)); }

struct EpiStoreBf16 {
    static constexpr bool PERM = true, AFTER_DRAIN = false;
    bf16_t* O; int ldc;
    __device__ __forceinline__ void operator()(const f32x4 (&acc)[2][2][4][2], const Unit& u, int wr, int wc, int fr, int fq) const {
        const int lane = fr + 16 * fq, row0 = u.pm * BM + wr * 64 + (lane >> 2), col0 = u.pn * BM + wc * 32 + 8 * (lane & 3);
#pragma unroll
        for (int ai = 0; ai < 2; ++ai)
#pragma unroll
            for (int m = 0; m < 4; ++m) { bf16_t* rowp = O + (size_t)(row0 + ai * HALF + m * 16) * ldc + col0;
#pragma unroll
                for (int bj = 0; bj < 2; ++bj) { const f32x4 v0 = acc[ai][bj][m][0], v1 = acc[ai][bj][m][1];
                    u32x4 w; w.x = cvt_pk_bf16(v0[0], v0[1]); w.y = cvt_pk_bf16(v0[2], v0[3]); w.z = cvt_pk_bf16(v1[0], v1[1]); w.w = cvt_pk_bf16(v1[2], v1[3]);
                    *(u32x4*)(rowp + bj * HALF) = quad_rows(w, lane); } }
    }
};
struct EpiSgIn {
    static constexpr bool PERM = true, AFTER_DRAIN = false;
    bf16_t* U; bf16_t* V; float* stats;
    __device__ __forceinline__ void operator()(const f32x4 (&acc)[2][2][4][2], const Unit& u, int wr, int wc, int fr, int fq) const {
        const bool isv = u.pn >= 8; bf16_t* base = isv ? V : U;
        const int lane = fr + 16 * fq, row0 = u.pm * BM + wr * 64 + fr, rowq = u.pm * BM + wr * 64 + (lane >> 2), col0 = (u.pn & 7) * BM + wc * 32 + 8 * (lane & 3);
#pragma unroll
        for (int ai = 0; ai < 2; ++ai)
#pragma unroll
            for (int m = 0; m < 4; ++m) { const int row = row0 + ai * HALF + m * 16; bf16_t* rowp = base + (size_t)(rowq + ai * HALF + m * 16) * 2048 + col0; float s = 0.f, q = 0.f;
#pragma unroll
                for (int bj = 0; bj < 2; ++bj) { f32x4 v0 = acc[ai][bj][m][0], v1 = acc[ai][bj][m][1];
                    f32x2 a = gelu_pk((f32x2){v0[0], v0[1]}), b = gelu_pk((f32x2){v0[2], v0[3]}), c = gelu_pk((f32x2){v1[0], v1[1]}), d = gelu_pk((f32x2){v1[2], v1[3]});
                    s += (a.x + a.y) + (b.x + b.y) + (c.x + c.y) + (d.x + d.y);
                    q += (a.x * a.x + a.y * a.y) + (b.x * b.x + b.y * b.y) + (c.x * c.x + c.y * c.y) + (d.x * d.x + d.y * d.y);
                    u32x4 w; w.x = cvt_pk_bf16(a.x, a.y); w.y = cvt_pk_bf16(b.x, b.y); w.z = cvt_pk_bf16(c.x, c.y); w.w = cvt_pk_bf16(d.x, d.y);
                    *(u32x4*)(rowp + bj * HALF) = quad_rows(w, lane); }
                if (isv) { s += __shfl_xor(s, 16); s += __shfl_xor(s, 32); q += __shfl_xor(q, 16); q += __shfl_xor(q, 32);
                    if (fq == 0) *(f32x2*)(stats + ((size_t)row * 32 + (u.pn - 8) * 4 + wc) * 2) = (f32x2){s, q}; } }
    }
};
struct EpiSwiglu {
    static constexpr bool PERM = true, AFTER_DRAIN = false;
    bf16_t* O;
    __device__ __forceinline__ void operator()(const f32x4 (&acc)[2][2][4][2], const Unit& u, int wr, int wc, int fr, int fq) const {
        const int lane = fr + 16 * fq, row0 = u.pm * BM + wr * 64 + (lane >> 2), col0 = u.pn * 128 + wc * 32 + 8 * (lane & 3);
#pragma unroll
        for (int ai = 0; ai < 2; ++ai)
#pragma unroll
            for (int m = 0; m < 4; ++m) { bf16_t* rowp = O + (size_t)(row0 + ai * HALF + m * 16) * 2816 + col0;
                const f32x4 a0 = acc[ai][0][m][0], a1 = acc[ai][0][m][1], b0 = acc[ai][1][m][0], b1 = acc[ai][1][m][1];
                u32x4 w; w.x = cvt_pk_bf16(silu_f(a0[0]) * b0[0], silu_f(a0[1]) * b0[1]); w.y = cvt_pk_bf16(silu_f(a0[2]) * b0[2], silu_f(a0[3]) * b0[3]);
                w.z = cvt_pk_bf16(silu_f(a1[0]) * b1[0], silu_f(a1[1]) * b1[1]); w.w = cvt_pk_bf16(silu_f(a1[2]) * b1[2], silu_f(a1[3]) * b1[3]);
                *(u32x4*)rowp = quad_rows(w, lane); }
    }
};

template <class Epi, class Sched, bool STAMP = false>
__device__ __forceinline__ void gemm_phase(PG8_LAS unsigned char* lds, const Gemm g, const Sched& S, const Epi& E, unsigned long long* stamps) {
    const int tid = tidx(), wid = __builtin_amdgcn_readfirstlane(tid >> 6), lane = tid & 63, wr = wid >> 2, wc = wid & 3, fr = lane & 15, fq = lane >> 4;
    const int K = g.K, nt = K / BK;
    int ts_lo = 0, ts_hi = 0, nts = 0; const unsigned long long rt_entry = STAMP ? (unsigned long long)wall_clock64() : 0ull;
#define PG8_STAMP() do { if (STAMP && wid == 0 && nts < 64) { const unsigned long long _c = (unsigned long long)clock64(); \
        ts_lo = (lane == nts) ? (int)(unsigned)_c : ts_lo; ts_hi = (lane == nts) ? (int)(unsigned)(_c >> 32) : ts_hi; ++nts; } } while (0)
    PG8_STAMP();
    unsigned voffA[2], voffB[2];
#pragma unroll
    for (int i = 0; i < 2; ++i) { int R, C; stage_rc(tid * 16 + i * 8192, R, C); const int Rb = Epi::PERM ? ((R & ~31) + perm32(R & 31)) : R;
        voffA[i] = (unsigned)(R * K + C) * 2u; voffB[i] = (unsigned)(Rb * K + C) * 2u; }
    const size_t kstep = (size_t)(BK * 2);
    const size_t hstep = (size_t)HALF * K * 2;
    const size_t tstep = 2 * hstep;
    const unsigned ldsw = (unsigned)wid * 1024u;
    const int aoff = lds_byte(wr * 64 + fr, fq * 8), boff = lds_byte(wc * 32 + fr, fq * 8);
#define PG8_SA(b, h) (((b) * 2 + (h)) * HTB)
#define PG8_SB(b, h) ((4 + (b) * 2 + (h)) * HTB)
#define PG8_STAGE(bufoff, gbase, voff) do { _Pragma("unroll") for (int _i = 0; _i < 2; ++_i) \
        __builtin_amdgcn_global_load_lds((const unsigned*)((const char*)(gbase) + (voff)[_i]), (PG8_LAS unsigned*)(lds + (bufoff) + ldsw + _i * 8192), 16, 0, 0); } while (0)
#define PG8_LDA(dst, b, h) do { _Pragma("unroll") for (int m = 0; m < 4; ++m) _Pragma("unroll") for (int k = 0; k < 2; ++k) dst[m][k] = *(const PG8_LAS bf16x8*)(lds + PG8_SA(b, h) + aoff + m * 2048 + k * 1024); } while (0)
#define PG8_LDB(dst, b, h) do { _Pragma("unroll") for (int n = 0; n < 2; ++n) _Pragma("unroll") for (int k = 0; k < 2; ++k) dst[n][k] = *(const PG8_LAS bf16x8*)(lds + PG8_SB(b, h) + boff + n * 2048 + k * 1024); } while (0)
#define PG8_MMA(ai, bj, At, Bt) do { __builtin_amdgcn_s_setprio(1); _Pragma("unroll") for (int m = 0; m < 4; ++m) _Pragma("unroll") for (int n = 0; n < 2; ++n) _Pragma("unroll") for (int k = 0; k < 2; ++k) \
        acc[ai][bj][m][n] = __builtin_amdgcn_mfma_f32_16x16x32_bf16(Bt[n][k], At[m][k], acc[ai][bj][m][n], 0, 0, 0); __builtin_amdgcn_s_setprio(0); } while (0)
#define PG8_WAIT_V(n) asm volatile("s_waitcnt vmcnt(" #n ")" ::: "memory")
#define PG8_WAIT_L(n) asm volatile("s_waitcnt lgkmcnt(" #n ")" ::: "memory")
#define PG8_BAR __builtin_amdgcn_s_barrier()
#define PG8_SCHED __builtin_amdgcn_sched_barrier(0)
    Unit cur, nxt; int ui = 0;
    if (!S.next(0, cur)) return;
    f32x4 acc[2][2][4][2];
#pragma unroll
    for (int a = 0; a < 2; ++a)
#pragma unroll
        for (int b = 0; b < 2; ++b)
#pragma unroll
            for (int m = 0; m < 4; ++m)
#pragma unroll
                for (int n = 0; n < 2; ++n) acc[a][b][m][n] = (f32x4){0.f, 0.f, 0.f, 0.f};
    bf16x8 At[4][2], B0[2][2], B1[2][2];
    const char* cA = (const char*)g.A + (size_t)cur.pm * tstep; const char* cB = (const char*)g.Bt + (size_t)cur.pn * tstep;
    S.a_ready(cur);
    PG8_STAGE(PG8_SB(0, 0), cB, voffB); PG8_STAGE(PG8_SA(0, 0), cA, voffA); PG8_STAGE(PG8_SB(0, 1), cB + hstep, voffB); PG8_STAGE(PG8_SA(0, 1), cA + hstep, voffA);
    if (wr == 1) PG8_BAR;
    PG8_WAIT_V(4); PG8_BAR;
    PG8_STAGE(PG8_SB(1, 0), cB + kstep, voffB); PG8_STAGE(PG8_SA(1, 0), cA + kstep, voffA); PG8_STAGE(PG8_SB(1, 1), cB + hstep + kstep, voffB);
    PG8_WAIT_V(6); PG8_BAR;
    PG8_STAMP();
    for (;;) {
        const bool has_next = S.next(ui + 1, nxt);
        const char* nA = has_next ? (const char*)g.A + (size_t)nxt.pm * tstep : cA; const char* nB = has_next ? (const char*)g.Bt + (size_t)nxt.pn * tstep : cB;
        for (int t = 0; t < nt; t += 2) {
            const bool last = (t == nt - 2);
            const char* a1 = cA + (size_t)(t + 1) * kstep;
            const char* a2 = last ? nA : cA + (size_t)(t + 2) * kstep; const char* b2 = last ? nB : cB + (size_t)(t + 2) * kstep;
            const char* a3 = a2 + kstep; const char* b3 = b2 + kstep;
            if (last && has_next) S.a_ready(nxt);
            PG8_LDB(B0, 0, 0); PG8_SCHED; PG8_LDA(At, 0, 0); PG8_STAGE(PG8_SA(1, 1), a1 + hstep, voffA);
            PG8_WAIT_L(8); PG8_BAR; PG8_WAIT_L(0); PG8_MMA(0, 0, At, B0); PG8_BAR; PG8_SCHED;
            PG8_LDB(B1, 0, 1); PG8_STAGE(PG8_SB(0, 0), b2, voffB);
            PG8_BAR; PG8_WAIT_L(0); PG8_MMA(0, 1, At, B1); PG8_BAR;
            PG8_LDA(At, 0, 1); PG8_STAGE(PG8_SA(0, 0), a2, voffA);
            PG8_BAR; PG8_WAIT_L(0); PG8_MMA(1, 0, At, B0); PG8_BAR; PG8_SCHED;
            PG8_STAGE(PG8_SB(0, 1), b2 + hstep, voffB);
            PG8_WAIT_V(6); PG8_BAR; PG8_MMA(1, 1, At, B1); PG8_BAR;
            PG8_LDB(B0, 1, 0); PG8_SCHED; PG8_LDA(At, 1, 0); PG8_STAGE(PG8_SA(0, 1), a2 + hstep, voffA);
            PG8_WAIT_L(8); PG8_BAR; PG8_WAIT_L(0); PG8_MMA(0, 0, At, B0); PG8_BAR; PG8_SCHED;
            PG8_LDB(B1, 1, 1); PG8_STAGE(PG8_SB(1, 0), b3, voffB);
            PG8_BAR; PG8_WAIT_L(0); PG8_MMA(0, 1, At, B1); PG8_BAR;
            PG8_LDA(At, 1, 1); PG8_STAGE(PG8_SA(1, 0), a3, voffA);
            PG8_BAR; PG8_WAIT_L(0); PG8_MMA(1, 0, At, B0); PG8_BAR; PG8_SCHED;
            PG8_STAGE(PG8_SB(1, 1), b3 + hstep, voffB);
            PG8_WAIT_V(6); PG8_BAR; PG8_MMA(1, 1, At, B1); PG8_BAR;
        }
        PG8_STAMP();
        if constexpr (!Epi::AFTER_DRAIN) { E(acc, cur, wr, wc, fr, fq); S.done(cur); }
        PG8_STAMP();
        if (!has_next) break;
#pragma unroll
        for (int a = 0; a < 2; ++a)
#pragma unroll
            for (int b = 0; b < 2; ++b)
#pragma unroll
                for (int m = 0; m < 4; ++m)
#pragma unroll
                    for (int n = 0; n < 2; ++n) acc[a][b][m][n] = (f32x4){0.f, 0.f, 0.f, 0.f};
        cur = nxt; cA = nA; cB = nB; ++ui;
    }
    PG8_WAIT_V(0);
    if (wr == 0) PG8_BAR;
    PG8_BAR;
    if constexpr (Epi::AFTER_DRAIN) { E.fused(acc, cur, wr, wc, fr, fq, lds, wid, lane); S.done(cur); }
    PG8_STAMP();
    if (STAMP && wid == 0) { stamps[lane] = lane < nts ? (((unsigned long long)(unsigned)ts_hi << 32) | (unsigned)ts_lo) : 0ull;
        if (lane == 62) stamps[62] = rt_entry; if (lane == 63) stamps[63] = (unsigned long long)wall_clock64(); }
#undef PG8_STAMP
#undef PG8_SA
#undef PG8_SB
#undef PG8_STAGE
#undef PG8_LDA
#undef PG8_LDB
#undef PG8_MMA
#undef PG8_WAIT_V
#undef PG8_WAIT_L
#undef PG8_BAR
#undef PG8_SCHED
}
}

using pg8::bf16_t; using pg8::bf16x8; using pg8::f32x4; using pg8::u32x4; using pg8::cvt_pk_bf16; using pg8::bf2f; using pg8::silu_f;
typedef unsigned u32x2 __attribute__((ext_vector_type(2)));
constexpr int DM = 1024, MPR = 16384, MSM = 128, MTOT = MPR + MSM, MP = 16640, SEQ = 2048;
constexpr int DFF = 2816, SGW = 2048;
constexpr float EPSN = 1e-6f;
constexpr int LDS_BYTES = 131072 + 64;
constexpr size_t O_Y = 0, O_SGVP = (size_t)MTOT * DM, O_SGVS = O_SGVP + (size_t)8 * 128 * 2048, O_STP = O_SGVS + (size_t)128 * 2048, O_STS = O_STP + (size_t)8 * 4 * 128 * 256;
constexpr size_t al256(size_t x) { return (x + 255) & ~(size_t)255; }
constexpr size_t W_SGIN = 0;
constexpr size_t W_SGOUT = W_SGIN + (size_t)4096 * 1024 * 2;
constexpr size_t W_13_0 = W_SGOUT + (size_t)1024 * 2048 * 2;
constexpr size_t W_2_0 = W_13_0 + (size_t)5632 * 1024 * 2;
constexpr size_t W_13_1 = W_2_0 + (size_t)1024 * 2816 * 2;
constexpr size_t W_2_1 = W_13_1 + (size_t)5632 * 1024 * 2;
constexpr size_t W_GLAIN = W_2_1 + (size_t)1024 * 2816 * 2;
constexpr size_t W_R = W_GLAIN + (size_t)3072 * 1024 * 2;
constexpr size_t W_GLAOUT = W_R + (size_t)32 * 1024 * 2;
constexpr size_t WS_HB = W_GLAOUT + (size_t)1024 * 1024 * 2;
constexpr size_t WS_R1 = WS_HB + (size_t)MP * 1024 * 2;
constexpr size_t WS_MBUF = WS_R1 + (size_t)MP * 3072 * 2;
constexpr size_t WS_RBUF = WS_R1 + (size_t)MP * 4096 * 2;
constexpr size_t WS_STATS = WS_RBUF + (size_t)MP * 16 * 4;
constexpr size_t WS_KDT = al256(WS_STATS + (size_t)MP * 32 * 2 * 4);
constexpr size_t WS_DLAST = WS_KDT + (size_t)1024 * 128 * 64 * 2;
constexpr size_t WS_STATS_S = WS_DLAST + (size_t)1024 * 128 * 4;
constexpr size_t WS_BAR = WS_STATS_S + (size_t)128 * 64 * 2 * 4;
constexpr size_t WS_END = WS_BAR + 32768;
constexpr size_t WS_QB = W_SGIN;
constexpr size_t WS_ATT = WS_QB + (size_t)MPR * 512 * 2;
static_assert(WS_END <= (size_t)256 * 1024 * 1024, "workspace too large");
static_assert((size_t)1024 * 256 * 64 * 2 <= (size_t)MP * 1024 * 2, "VT must fit the MBUF region");

struct Params {
    const float *x_prompt, *x_sample, *state_gla, *norm_g, *ffn_w13, *ffn_w2, *sg_w_in, *sg_ln_g, *sg_ln_b, *sg_w_s, *sg_b_s, *sg_w_out,
                *gla_w_in, *gla_w_gate_up, *gla_b_gate, *gla_out_norm_g, *gla_w_out;
    float* out; unsigned char* ws;
};

__device__ __forceinline__ float wave_sum(float v) {
#pragma unroll
    for (int o = 1; o < 64; o <<= 1) v += __shfl_xor(v, o);
    return v;
}
#define LDS_WAIT() asm volatile("s_waitcnt lgkmcnt(0)" ::: "memory")
__device__ __forceinline__ u32x4 frag_ld(const bf16_t* p0, size_t rs, int lane) { return *(const u32x4*)(p0 + (size_t)(lane >> 2) * rs + 8 * (lane & 3)); }
__device__ __forceinline__ bf16x8 frag_perm(const u32x4 v, int lane) {
    const int src = (4 * (lane & 15) + (lane >> 4)) * 4; u32x4 r;
    r.x = (unsigned)__builtin_amdgcn_ds_bpermute(src, (int)v.x); r.y = (unsigned)__builtin_amdgcn_ds_bpermute(src, (int)v.y);
    r.z = (unsigned)__builtin_amdgcn_ds_bpermute(src, (int)v.z); r.w = (unsigned)__builtin_amdgcn_ds_bpermute(src, (int)v.w);
    return __builtin_bit_cast(bf16x8, r); }
__device__ __forceinline__ int vbid() { extern __shared__ __attribute__((aligned(16))) unsigned char shm_[]; return (int)*(volatile __attribute__((address_space(3))) unsigned*)(__attribute__((address_space(3))) unsigned char*)(shm_ + 131072 + 16); }
__device__ __forceinline__ bool xloc() { extern __shared__ __attribute__((aligned(16))) unsigned char shm_[]; return *(volatile __attribute__((address_space(3))) unsigned*)(__attribute__((address_space(3))) unsigned char*)(shm_ + 131072 + 20) != 0u; }
__device__ __forceinline__ int xcls() { return vbid() & 7; }
__device__ __forceinline__ int xidx() { return vbid() >> 3; }
__device__ __forceinline__ int xper() { return (int)(gridDim.x >> 3); }

__device__ __forceinline__ void transpose_item(const float* __restrict__ W, int ldw, int cmax, bf16_t* __restrict__ WT, int K, int k0, int c0, int n0, float* scr, int lane) {
    const int c = c0 + (lane & 31); const bool ok = c < cmax;
#pragma unroll 8
    for (int i = 0; i < 32; ++i) { const int kk = 2 * i + (lane >> 5); scr[kk * 33 + (lane & 31)] = ok ? W[(size_t)(k0 + kk) * ldw + c] : 0.f; }
    LDS_WAIT();
    const int cc = lane & 7;
#pragma unroll
    for (int j = 0; j < 4; ++j) { const int n = (lane >> 3) + 8 * j; const float* s = scr + (8 * cc) * 33 + n;
        u32x4 o; o.x = cvt_pk_bf16(s[0 * 33], s[1 * 33]); o.y = cvt_pk_bf16(s[2 * 33], s[3 * 33]); o.z = cvt_pk_bf16(s[4 * 33], s[5 * 33]); o.w = cvt_pk_bf16(s[6 * 33], s[7 * 33]);
        *(u32x4*)(WT + (size_t)(n0 + n) * K + k0 + 8 * cc) = o; }
    LDS_WAIT();
}

__device__ __forceinline__ const float* x_in_row(const Params& p, int row) { return row < MPR ? p.x_prompt + (size_t)row * DM : p.x_sample + (size_t)(row - MPR) * DM; }

__device__ __forceinline__ void norm_row(const Params& p, int row, int lane, int mode, const float* __restrict__ g_res, const float* __restrict__ g_h, bool x_from_input) {
    const bf16_t* MB = (const bf16_t*)(p.ws + WS_MBUF); bf16_t* HB = (bf16_t*)(p.ws + WS_HB);
    const float* xin = x_from_input ? x_in_row(p, row) : (const float*)(p.out + (size_t)row * DM);
    f32x4 v[4];
#pragma unroll
    for (int j = 0; j < 4; ++j) v[j] = *(const f32x4*)(xin + 4 * lane + 256 * j);
    if (mode != 0) {
        f32x4 mv[4]; float ss = 0.f;
#pragma unroll
        for (int j = 0; j < 4; ++j) { const u32x2 w = *(const u32x2*)(MB + (size_t)row * DM + 4 * lane + 256 * j);
            mv[j] = (f32x4){__uint_as_float(w.x << 16), __uint_as_float(w.x & 0xffff0000u), __uint_as_float(w.y << 16), __uint_as_float(w.y & 0xffff0000u)};
            ss += (mv[j][0] * mv[j][0] + mv[j][1] * mv[j][1]) + (mv[j][2] * mv[j][2] + mv[j][3] * mv[j][3]); }
        const float rs = rsqrtf(wave_sum(ss) * (1.0f / DM) + EPSN);
#pragma unroll
        for (int j = 0; j < 4; ++j) { const f32x4 g = *(const f32x4*)(g_res + 4 * lane + 256 * j); v[j] = v[j] + mv[j] * rs * g;
            *(f32x4*)(p.out + (size_t)row * DM + 4 * lane + 256 * j) = v[j]; }
    }
    if (mode != 2) {
        float ss = 0.f;
#pragma unroll
        for (int j = 0; j < 4; ++j) ss += (v[j][0] * v[j][0] + v[j][1] * v[j][1]) + (v[j][2] * v[j][2] + v[j][3] * v[j][3]);
        const float rs = rsqrtf(wave_sum(ss) * (1.0f / DM) + EPSN);
#pragma unroll
        for (int j = 0; j < 4; ++j) { const f32x4 g = *(const f32x4*)(g_h + 4 * lane + 256 * j); const f32x4 h = v[j] * rs * g;
            u32x2 w; w.x = cvt_pk_bf16(h[0], h[1]); w.y = cvt_pk_bf16(h[2], h[3]);
            *(u32x2*)(HB + (size_t)row * DM + 4 * lane + 256 * j) = w; }
    }
}
__device__ __forceinline__ void norm_phase(const Params& p, int mode, const float* __restrict__ g_res, const float* __restrict__ g_h, bool x_from_input) {
    const int lane = tidx() & 63, wave = tidx() >> 6;
    if (xloc()) {
        for (int rl = xidx() * 8 + wave; rl < SEQ; rl += xper() * 8) norm_row(p, xcls() * SEQ + rl, lane, mode, g_res, g_h, x_from_input);
        const int li = xidx() * 8 + wave; if (li < 16) norm_row(p, MPR + 16 * xcls() + li, lane, mode, g_res, g_h, x_from_input);
    } else {
        for (int row = vbid() * 8 + wave; row < MTOT; row += gridDim.x * 8) norm_row(p, row, lane, mode, g_res, g_h, x_from_input);
    }
}

__device__ __forceinline__ void convert_weights(const Params& p, unsigned char* lds, bool late, int gw, int NGW) {
    const int lane = tidx() & 63, wave = tidx() >> 6;
    float* scr = (float*)(lds + wave * 8704);
    constexpr int I_SGIN = 16 * 128, I_SGOUT = 32 * 32, I_13 = 16 * 176, I_2 = 44 * 32, I_GLAIN = 16 * 96, I_R = 16, I_GLAOUT = 16 * 32;
    constexpr int NITEMS = I_SGIN + I_SGOUT + 2 * I_13 + 2 * I_2 + I_GLAIN + I_R + I_GLAOUT;
    for (int it = gw; it < NITEMS; it += NGW) {
        int r = it;
        if (r < I_SGIN) { if (late) continue; const int kb = r / 128, nb = r % 128; transpose_item(p.sg_w_in, 4096, 4096, (bf16_t*)(p.ws + W_SGIN), 1024, 64 * kb, 32 * nb, 32 * nb, scr, lane); continue; } r -= I_SGIN;
        if (r < I_SGOUT) { if (late) continue; const int kb = r / 32, nb = r % 32; transpose_item(p.sg_w_out, 1024, 1024, (bf16_t*)(p.ws + W_SGOUT), 2048, 64 * kb, 32 * nb, 32 * nb, scr, lane); continue; } r -= I_SGOUT;
        if (r < 2 * I_13) { const int l = r / I_13; if (late != (l == 1)) continue; r -= l * I_13; const int kb = r / 176, nb = r % 176, n0 = 32 * nb;
            const int c0 = ((n0 >> 7) & 1) * DFF + 128 * (n0 >> 8) + (n0 & 127);
            transpose_item(p.ffn_w13 + (size_t)l * 1024 * 5632, 5632, 5632, (bf16_t*)(p.ws + (l ? W_13_1 : W_13_0)), 1024, 64 * kb, c0, n0, scr, lane); continue; } r -= 2 * I_13;
        if (r < 2 * I_2) { const int l = r / I_2; if (late != (l == 1)) continue; r -= l * I_2; const int kb = r / 32, nb = r % 32;
            transpose_item(p.ffn_w2 + (size_t)l * 2816 * 1024, 1024, 1024, (bf16_t*)(p.ws + (l ? W_2_1 : W_2_0)), 2816, 64 * kb, 32 * nb, 32 * nb, scr, lane); continue; } r -= 2 * I_2;
        if (late) continue;
        if (r < I_GLAIN) { const int kb = r / 96, nb = r % 96; transpose_item(p.gla_w_in, 3088, 3088, (bf16_t*)(p.ws + W_GLAIN), 1024, 64 * kb, 32 * nb, 32 * nb, scr, lane); continue; } r -= I_GLAIN;
        if (r < I_R) { transpose_item(p.gla_w_in, 3088, 3088, (bf16_t*)(p.ws + W_R), 1024, 64 * r, 3072, 0, scr, lane); continue; } r -= I_R;
        { const int kb = r / 32, nb = r % 32; transpose_item(p.gla_w_out, 1024, 1024, (bf16_t*)(p.ws + W_GLAOUT), 1024, 64 * kb, 32 * nb, 32 * nb, scr, lane); }
    }
}
__device__ __forceinline__ void phase0(const Params& p, unsigned char* lds) {
    const int tid = tidx(), wave = tid >> 6;
    convert_weights(p, lds, false, vbid() * 8 + wave, (int)gridDim.x * 8);
    { unsigned* hp = (unsigned*)(p.ws + WS_HB + (size_t)MTOT * DM * 2); for (int i = vbid() * 512 + tid; i < (MP - MTOT) * DM / 2; i += gridDim.x * 512) hp[i] = 0u; }
    norm_phase(p, 0, nullptr, p.norm_g, true);
}

__device__ __forceinline__ int vt_h(int vrow) { return ((vrow >> 5) & 1) | (((vrow >> 3) & 1) << 1); }
__device__ __forceinline__ void unpack8(const u32x4 w, float* f) {
    f[0] = __uint_as_float(w.x << 16); f[1] = __uint_as_float(w.x & 0xffff0000u); f[2] = __uint_as_float(w.y << 16); f[3] = __uint_as_float(w.y & 0xffff0000u);
    f[4] = __uint_as_float(w.z << 16); f[5] = __uint_as_float(w.z & 0xffff0000u); f[6] = __uint_as_float(w.w << 16); f[7] = __uint_as_float(w.w & 0xffff0000u);
}
__device__ __forceinline__ void sgu_phase(const Params& p, unsigned char* lds) {
    const int tid = tidx(), lane = tid & 63, wave = tid >> 6, fr = lane & 15, fq = lane >> 4;
    bf16_t* UB = (bf16_t*)(p.ws + WS_R1); const bf16_t* VB = (const bf16_t*)(p.ws + WS_R1 + (size_t)MP * 2048 * 2); const float* stats = (const float*)(p.ws + WS_STATS);
    const bool xaff0 = xloc();
    for (int lt = xaff0 ? xidx() * 512 + tid : vbid() * 512 + tid; lt < (xaff0 ? 16 * 256 : MSM * 256); lt += (xaff0 ? xper() : (int)gridDim.x) * 512) {
        const int task = xaff0 ? xcls() * 16 * 256 + lt : lt;
        const int r = task >> 8, col = (task & 255) * 8, g = col >> 8, row = MPR + r;
        float ssum = 0.f, sq = 0.f;
#pragma unroll
        for (int i = 0; i < 32; ++i) { const f32x4 t4 = *(const f32x4*)((const float*)(p.ws + WS_STATS_S) + (size_t)r * 128 + 4 * i); ssum += t4[0] + t4[2]; sq += t4[1] + t4[3]; }
        const float mean = ssum * (1.0f / SGW), var = sq * (1.0f / SGW) - mean * mean, rstd = rsqrtf(fmaxf(var, 0.f) + EPSN);
        float vv[8], uu[8]; unpack8(*(const u32x4*)(VB + (size_t)row * SGW + col), vv); unpack8(*(const u32x4*)(UB + (size_t)row * SGW + col), uu);
        const float w00 = p.sg_w_s[(size_t)g * 128 * 128], b0 = p.sg_b_s[g * 128];
        float vn[8], ga[8];
#pragma unroll
        for (int i = 0; i < 8; ++i) { vn[i] = (vv[i] - mean) * rstd * p.sg_ln_g[col + i] + p.sg_ln_b[col + i]; ga[i] = uu[i] * (w00 * vn[i] + b0); }
        float* so = p.out + O_SGVS + (size_t)r * SGW + col;
        *(f32x4*)so = (f32x4){vn[0], vn[1], vn[2], vn[3]}; *(f32x4*)(so + 4) = (f32x4){vn[4], vn[5], vn[6], vn[7]};
        u32x4 w; w.x = cvt_pk_bf16(ga[0], ga[1]); w.y = cvt_pk_bf16(ga[2], ga[3]); w.z = cvt_pk_bf16(ga[4], ga[5]); w.w = cvt_pk_bf16(ga[6], ga[7]);
        *(u32x4*)(UB + (size_t)row * SGW + col) = w;
    }
    unsigned char* WL = lds; unsigned char* VT = lds + 34816; pg8::f32x2* MR = (pg8::f32x2*)(lds + 104448);
    int staged_g = -1;
    const int wr = wave >> 2, wc = wave & 3;
    const bool xaff = xloc();
    for (int lu = xaff ? xidx() : (int)vbid(); lu < (xaff ? 128 : 1024); lu += xaff ? xper() : (int)gridDim.x) {
        const int unit = xaff ? xcls() * 128 + lu : lu;
        const int g = unit & 7, chunk = unit >> 3, r0 = chunk * 128, c0 = g * 256;
        __syncthreads();
        if (g != staged_g) { staged_g = g;
#pragma unroll
            for (int it = 0; it < 4; ++it) { const int idx = it * 512 + tid, t = idx >> 4, s0 = (idx & 15) * 8;
                const float* src = p.sg_w_s + ((size_t)g * 128 + t) * 128 + s0; const f32x4 a = *(const f32x4*)src, b = *(const f32x4*)(src + 4);
                float f[8] = {a[0], a[1], a[2], a[3], b[0], b[1], b[2], b[3]};
#pragma unroll
                for (int i = 0; i < 8; ++i) f[i] = (s0 + i <= t) ? f[i] : 0.f;
                u32x4 w; w.x = cvt_pk_bf16(f[0], f[1]); w.y = cvt_pk_bf16(f[2], f[3]); w.z = cvt_pk_bf16(f[4], f[5]); w.w = cvt_pk_bf16(f[6], f[7]);
                *(u32x4*)(WL + t * 272 + s0 * 2) = w; } }
        { const int rl = tid >> 2, part = tid & 3; float ssum = 0.f, sq = 0.f;
#pragma unroll
          for (int i = 0; i < 4; ++i) { const f32x4 t4 = *(const f32x4*)(stats + (size_t)(r0 + rl) * 64 + 4 * part + 16 * i); ssum += t4[0] + t4[2]; sq += t4[1] + t4[3]; }
          ssum += __shfl_xor(ssum, 1); sq += __shfl_xor(sq, 1); ssum += __shfl_xor(ssum, 2); sq += __shfl_xor(sq, 2);
          const float mean = ssum * (1.0f / SGW), rstd = rsqrtf(fmaxf(sq * (1.0f / SGW) - mean * mean, 0.f) + EPSN);
          if (part == 0) MR[rl] = (pg8::f32x2){mean, rstd}; }
        __syncthreads();
        const bool lastc = (chunk & 15) == 15; const int bb = chunk >> 4;
#pragma unroll
        for (int it = 0; it < 4; ++it) {
            const int block = it * 8 + wave, colblk = block & 3, tokblk = block >> 2, cgp = lane & 7, spl = (lane >> 3) & 3, chl = lane >> 5;
            const int s = 16 * tokblk + 8 * chl + 2 * spl, colL = 64 * colblk + 8 * cgp, rowA = r0 + s;
            float va[8], vb[8]; unpack8(*(const u32x4*)(VB + (size_t)rowA * SGW + c0 + colL), va); unpack8(*(const u32x4*)(VB + (size_t)(rowA + 1) * SGW + c0 + colL), vb);
            const f32x4 st = *(const f32x4*)(MR + s);
            const float meanA = st[0], rstdA = st[1], meanB = st[2], rstdB = st[3];
            const f32x4 g0 = *(const f32x4*)(p.sg_ln_g + c0 + colL), g1 = *(const f32x4*)(p.sg_ln_g + c0 + colL + 4), b0 = *(const f32x4*)(p.sg_ln_b + c0 + colL), b1 = *(const f32x4*)(p.sg_ln_b + c0 + colL + 4);
            const float gg[8] = {g0[0], g0[1], g0[2], g0[3], g1[0], g1[1], g1[2], g1[3]}, bbv[8] = {b0[0], b0[1], b0[2], b0[3], b1[0], b1[1], b1[2], b1[3]};
#pragma unroll
            for (int i = 0; i < 8; ++i) { va[i] = (va[i] - meanA) * rstdA * gg[i] + bbv[i]; vb[i] = (vb[i] - meanB) * rstdB * gg[i] + bbv[i]; }
            if (lastc) { float* so = p.out + O_SGVP + ((size_t)(bb * 128 + s)) * SGW + c0 + colL;
                *(f32x4*)so = (f32x4){va[0], va[1], va[2], va[3]}; *(f32x4*)(so + 4) = (f32x4){va[4], va[5], va[6], va[7]};
                *(f32x4*)(so + SGW) = (f32x4){vb[0], vb[1], vb[2], vb[3]}; *(f32x4*)(so + SGW + 4) = (f32x4){vb[4], vb[5], vb[6], vb[7]}; }
#pragma unroll
            for (int i = 0; i < 8; ++i) { const int c = colL + i; const int vrow = (c & ~63) | (((c >> 2) & 3) << 4) | (((c >> 4) & 3) << 2) | (c & 3);
                const int pch = (s >> 3) ^ vt_h(vrow);
                *(unsigned*)(VT + vrow * 272 + (pch * 8 + (s & 7)) * 2) = cvt_pk_bf16(va[i], vb[i]); }
        }
        __syncthreads();
        f32x4 acc[4][4];
#pragma unroll
        for (int a = 0; a < 4; ++a)
#pragma unroll
            for (int b = 0; b < 4; ++b) acc[a][b] = (f32x4){0.f, 0.f, 0.f, 0.f};
#pragma unroll
        for (int ks = 0; ks < 4; ++ks) {
            if (32 * ks <= 64 * wr + 63) {
                bf16x8 bfr[4];
#pragma unroll
                for (int ni = 0; ni < 4; ++ni) { const int vrow = 64 * wc + 16 * ni + fr; bfr[ni] = *(const bf16x8*)(VT + vrow * 272 + (((4 * ks + fq) ^ vt_h(vrow)) * 16)); }
#pragma unroll
                for (int mi = 0; mi < 4; ++mi) {
                    if (32 * ks <= 64 * wr + 16 * mi + 15) {
                        const bf16x8 af = *(const bf16x8*)(WL + (64 * wr + 16 * mi + fr) * 272 + (32 * ks + 8 * fq) * 2);
#pragma unroll
                        for (int ni = 0; ni < 4; ++ni) acc[mi][ni] = __builtin_amdgcn_mfma_f32_16x16x32_bf16(bfr[ni], af, acc[mi][ni], 0, 0, 0);
                    } } } }
#pragma unroll
        for (int mi = 0; mi < 4; ++mi) {
            const int t = 64 * wr + 16 * mi + fr; const float bias = p.sg_b_s[g * 128 + t];
            bf16_t* up = UB + (size_t)(r0 + t) * SGW + c0 + 64 * wc + 16 * fq;
            float u0[8], u1[8]; unpack8(*(const u32x4*)up, u0); unpack8(*(const u32x4*)(up + 8), u1);
            u32x4 w0, w1;
            w0.x = cvt_pk_bf16(u0[0] * (acc[mi][0][0] + bias), u0[1] * (acc[mi][0][1] + bias)); w0.y = cvt_pk_bf16(u0[2] * (acc[mi][0][2] + bias), u0[3] * (acc[mi][0][3] + bias));
            w0.z = cvt_pk_bf16(u0[4] * (acc[mi][1][0] + bias), u0[5] * (acc[mi][1][1] + bias)); w0.w = cvt_pk_bf16(u0[6] * (acc[mi][1][2] + bias), u0[7] * (acc[mi][1][3] + bias));
            w1.x = cvt_pk_bf16(u1[0] * (acc[mi][2][0] + bias), u1[1] * (acc[mi][2][1] + bias)); w1.y = cvt_pk_bf16(u1[2] * (acc[mi][2][2] + bias), u1[3] * (acc[mi][2][3] + bias));
            w1.z = cvt_pk_bf16(u1[4] * (acc[mi][3][0] + bias), u1[5] * (acc[mi][3][1] + bias)); w1.w = cvt_pk_bf16(u1[6] * (acc[mi][3][2] + bias), u1[7] * (acc[mi][3][3] + bias));
            *(u32x4*)up = w0; *(u32x4*)(up + 8) = w1;
        }
    }
}

__device__ __forceinline__ void gla_r_tasks(const Params& p) {
    const int lane = tidx() & 63, wave = tidx() >> 6, fr = lane & 15, fq = lane >> 4;
    const bf16_t* HB = (const bf16_t*)(p.ws + WS_HB); const bf16_t* WR = (const bf16_t*)(p.ws + W_R); float* RB = (float*)(p.ws + WS_RBUF);
    const bool xaff = xloc();
    const int ntl = xaff ? 128 + (xidx() * 8 + wave == 0 ? 1 : 0) : MTOT / 16;
    for (int tl = xaff ? xidx() * 8 + wave : (int)vbid() * 8 + wave; tl < ntl; tl += (xaff && tl + xper() * 8 >= 128 && tl < 128) ? 128 - tl : (xaff ? xper() * 8 : (int)gridDim.x * 8)) {
        const int task = xaff ? (tl < 128 ? xcls() * 128 + tl : 1024 + xcls()) : tl;
        const int row0 = task * 16; f32x4 acc = (f32x4){0.f, 0.f, 0.f, 0.f};
#pragma unroll 8
        for (int ks = 0; ks < 32; ++ks) {
            const bf16x8 a = frag_perm(frag_ld(WR + 32 * ks, DM, lane), lane), b = frag_perm(frag_ld(HB + (size_t)row0 * DM + 32 * ks, DM, lane), lane);
            acc = __builtin_amdgcn_mfma_f32_16x16x32_bf16(a, b, acc, 0, 0, 0); }
        *(f32x4*)(RB + (size_t)(row0 + fr) * 16 + 4 * fq) = acc;
    }
}
__device__ __forceinline__ float logsig16(float x) { return (fminf(x, 0.f) - __logf(1.0f + __expf(-fabsf(x)))) * (1.0f / 16.0f); }

__device__ __forceinline__ void gla_prep_phase(const Params& p, unsigned char* lds) {
    const int tid = tidx(), lane = tid & 63, wave = tid >> 6, fr = lane & 15, fq = lane >> 4;
    const bf16_t* QKVG = (const bf16_t*)(p.ws + WS_R1); const float* RB = (const float*)(p.ws + WS_RBUF);
    bf16_t* QKVGw = (bf16_t*)(p.ws + WS_R1); bf16_t* KDTg = (bf16_t*)(p.ws + WS_KDT); bf16_t* VTg = (bf16_t*)(p.ws + WS_MBUF);
    float* DL = (float*)(p.ws + WS_DLAST); bf16_t* OB = (bf16_t*)(p.ws + WS_HB);
    float* RL = (float*)lds;
    float* TOT = (float*)(lds + 4096);
    unsigned char* QL = lds + 6144;
    unsigned char* KL = lds + 6144 + 17408;
    unsigned char* VL = lds + 6144 + 2 * 17408;
    const float scale = 0.08838834764831845f;
    const bool xaff = xloc();
    for (int lu = xaff ? xidx() : (int)vbid(); lu < (xaff ? 128 : 1024); lu += xaff ? xper() : (int)gridDim.x) {
        const int u = xaff ? xcls() * 128 + lu : lu;
        const int c = u & 31, h = (u >> 5) & 3, b = u >> 7, row0 = b * SEQ + 64 * c;
        __syncthreads();
        if (tid < 256) *(f32x4*)(RL + 4 * tid) = *(const f32x4*)(RB + (size_t)row0 * 16 + 4 * tid);
        const int kc = tid & 127, tq = tid >> 7;
        float wg[16];
#pragma unroll
        for (int j = 0; j < 16; ++j) wg[j] = p.gla_w_gate_up[j * 512 + 128 * h + kc];
        const float bg = p.gla_b_gate[128 * h + kc];
        __syncthreads();
        float cum[16]; float run = 0.f;
#pragma unroll
        for (int i = 0; i < 16; ++i) { const float* rr = RL + (16 * tq + i) * 16; float x = bg;
#pragma unroll
            for (int j = 0; j < 16; ++j) x += rr[j] * wg[j];
            run += logsig16(x); cum[i] = run; }
        TOT[tq * 128 + kc] = run;
        __syncthreads();
        float off = 0.f, blast = 0.f;
#pragma unroll
        for (int q = 0; q < 4; ++q) { const float tv = TOT[q * 128 + kc]; blast += tv; off += (q < tq) ? tv : 0.f; }
        unsigned kdp[8];
#pragma unroll
        for (int i = 0; i < 16; i += 2) {
            float kd2[2];
#pragma unroll
            for (int e = 0; e < 2; ++e) { const int t = 16 * tq + i + e; const float bbv = off + cum[i + e];
                const float qv = bf2f(QKVG[(size_t)(row0 + t) * 3072 + 128 * h + kc]), kv = bf2f(QKVG[(size_t)(row0 + t) * 3072 + 512 + 128 * h + kc]);
                const float qb = qv * scale * __expf(bbv), kb = kv * __expf(-bbv); kd2[e] = kv * __expf(blast - bbv);
                const unsigned short qh = (unsigned short)(cvt_pk_bf16(qb, 0.f) & 0xffffu), kh = (unsigned short)(cvt_pk_bf16(kb, 0.f) & 0xffffu);
                *(unsigned short*)(QL + t * 272 + kc * 2) = qh; *(unsigned short*)(KL + t * 272 + kc * 2) = kh;
                QKVGw[(size_t)(row0 + t) * 3072 + 128 * h + kc] = qh; }
            kdp[i >> 1] = cvt_pk_bf16(kd2[0], kd2[1]); }
        { bf16_t* kp = KDTg + ((size_t)u * 128 + kc) * 64 + 16 * tq;
          *(u32x4*)kp = (u32x4){kdp[0], kdp[1], kdp[2], kdp[3]}; *(u32x4*)(kp + 8) = (u32x4){kdp[4], kdp[5], kdp[6], kdp[7]}; }
        if (tq == 0) DL[u * 128 + kc] = __expf(blast);
        __syncthreads();
        { const int tb = wave >> 1;
#pragma unroll
          for (int e = 0; e < 2; ++e) { const int sb = 2 * (wave & 1) + e; f32x4 acc = (f32x4){0.f, 0.f, 0.f, 0.f};
              if (sb <= tb) {
#pragma unroll
                  for (int ks = 0; ks < 4; ++ks) { const bf16x8 a = *(const bf16x8*)(KL + (16 * sb + fr) * 272 + (32 * ks + 8 * fq) * 2), bq = *(const bf16x8*)(QL + (16 * tb + fr) * 272 + (32 * ks + 8 * fq) * 2);
                      acc = __builtin_amdgcn_mfma_f32_16x16x32_bf16(a, bq, acc, 0, 0, 0); } }
              const int t = 16 * tb + fr, s0 = 16 * sb + 4 * fq;
              u32x2 w; w.x = cvt_pk_bf16(s0 + 0 <= t ? acc[0] : 0.f, s0 + 1 <= t ? acc[1] : 0.f); w.y = cvt_pk_bf16(s0 + 2 <= t ? acc[2] : 0.f, s0 + 3 <= t ? acc[3] : 0.f);
              *(u32x2*)(QKVGw + (size_t)(row0 + t) * 3072 + 512 + 128 * h + s0) = w; } }
    }
    float* AL = (float*)lds; float* QS = AL + 128; float* KS = QS + 128; float* OP = KS + 128;
    for (int lu = xaff ? xidx() : vbid(); lu < (xaff ? 64 : MSM * 4); lu += xaff ? xper() : (int)gridDim.x) {
        const int u = xaff ? xcls() * 64 + lu : lu;
        const int b = u >> 2, h = u & 3, row = MPR + b;
        __syncthreads();
        if (tid < 128) { float x = p.gla_b_gate[128 * h + tid];
#pragma unroll
            for (int j = 0; j < 16; ++j) x += RB[(size_t)row * 16 + j] * p.gla_w_gate_up[j * 512 + 128 * h + tid];
            AL[tid] = __expf(logsig16(x)); QS[tid] = bf2f(QKVG[(size_t)row * 3072 + 128 * h + tid]) * scale; KS[tid] = bf2f(QKVG[(size_t)row * 3072 + 512 + 128 * h + tid]); }
        const int j4 = (tid & 63) * 4, kq = tid >> 6;
        const u32x2 vw = *(const u32x2*)(QKVG + (size_t)row * 3072 + 1024 + 256 * h + j4);
        const f32x4 vv = (f32x4){__uint_as_float(vw.x << 16), __uint_as_float(vw.x & 0xffff0000u), __uint_as_float(vw.y << 16), __uint_as_float(vw.y & 0xffff0000u)};
        __syncthreads();
        f32x4 oacc = (f32x4){0.f, 0.f, 0.f, 0.f};
        const size_t sbase = ((size_t)(b * 4 + h) * 128) * 256 + j4;
#pragma unroll 4
        for (int i = 0; i < 16; ++i) { const int kcc = 16 * kq + i; const f32x4 s0 = *(const f32x4*)(p.state_gla + sbase + (size_t)kcc * 256);
            const f32x4 sn = s0 * AL[kcc] + vv * KS[kcc]; *(f32x4*)(p.out + O_STS + sbase + (size_t)kcc * 256) = sn; oacc = oacc + sn * QS[kcc]; }
        *(f32x4*)(OP + kq * 256 + j4) = oacc;
        __syncthreads();
        if (tid < 256) { float o = 0.f;
#pragma unroll
            for (int q = 0; q < 8; ++q) o += OP[q * 256 + tid];
            OB[(size_t)row * DM + 256 * h + tid] = (unsigned short)(cvt_pk_bf16(o, 0.f) & 0xffffu); }
    }
}

constexpr int SC_ST = 0, SC_BUF0 = 2 * 8704, SC_QB = 0, SC_ATT = 17408, SC_KDT = 17408 + 9216, SC_VT = 17408 + 9216 + 18432, SC_BUFSZ = 17408 + 9216 + 18432 + 4608;
struct ScanStage { u32x4 qb[2], att, kdt[2], vt; f32x4 dl; };
__device__ __forceinline__ void scan_stage_load(ScanStage& R, const Params& p, int pu, int row0, int h, int vs, int kcb, int fq, int tid) {
    const bf16_t* QKVG = (const bf16_t*)(p.ws + WS_R1); const bf16_t* KDTg = (const bf16_t*)(p.ws + WS_KDT); const bf16_t* VTg = (const bf16_t*)(p.ws + WS_MBUF);
    const float* DL = (const float*)(p.ws + WS_DLAST);
#pragma unroll
    for (int j = 0; j < 2; ++j) { const int idx = tid + 512 * j;
        R.qb[j] = *(const u32x4*)(QKVG + (size_t)(row0 + (idx >> 4)) * 3072 + 128 * h + 8 * (idx & 15));
        R.kdt[j] = *(const u32x4*)(KDTg + ((size_t)pu * 128 + (idx >> 3)) * 64 + 8 * (idx & 7)); }
    R.att = *(const u32x4*)(QKVG + (size_t)(row0 + (tid >> 3)) * 3072 + 512 + 128 * h + 8 * (tid & 7));
    if (tid < 256) R.vt = *(const u32x4*)(QKVG + (size_t)(row0 + (tid >> 2)) * 3072 + 1024 + 256 * h + 32 * vs + 8 * (tid & 3));
    R.dl = *(const f32x4*)(DL + pu * 128 + 16 * kcb + 4 * fq);
}
__device__ __forceinline__ void scan_stage_write(const ScanStage& R, unsigned char* buf, int tid) {
#pragma unroll
    for (int j = 0; j < 2; ++j) { const int idx = tid + 512 * j;
        *(u32x4*)(buf + SC_QB + (idx >> 4) * 272 + (idx & 15) * 16) = R.qb[j];
        *(u32x4*)(buf + SC_KDT + (idx >> 3) * 144 + (idx & 7) * 16) = R.kdt[j]; }
    *(u32x4*)(buf + SC_ATT + (tid >> 3) * 144 + (tid & 7) * 16) = R.att;
    if (tid < 256) { const int sv = tid >> 2, j0 = 8 * (tid & 3); const unsigned w[4] = {R.vt.x, R.vt.y, R.vt.z, R.vt.w};
#pragma unroll
        for (int i = 0; i < 4; ++i) { *(unsigned short*)(buf + SC_VT + (j0 + 2 * i) * 144 + sv * 2) = (unsigned short)(w[i] & 0xffffu); *(unsigned short*)(buf + SC_VT + (j0 + 2 * i + 1) * 144 + sv * 2) = (unsigned short)(w[i] >> 16); } }
}
__device__ __forceinline__ void scan_step(const unsigned char* buf, const f32x4 dl, f32x4 (&accS)[2], const unsigned char* STr, unsigned char* STw, bf16_t* OB, const ScanStage& wr, bool do_write, unsigned char* nbuf,
                                          int row0, int h, int vs, int tb, int jbo, int kcb, int fr, int fq, int tid) {
    bf16x8 vf[2][2], kdf[2];
#pragma unroll
    for (int ks = 0; ks < 2; ++ks) { kdf[ks] = *(const bf16x8*)(buf + SC_KDT + (16 * kcb + fr) * 144 + (32 * ks + 8 * fq) * 2);
#pragma unroll
        for (int jb = 0; jb < 2; ++jb) vf[jb][ks] = *(const bf16x8*)(buf + SC_VT + (16 * jb + fr) * 144 + (32 * ks + 8 * fq) * 2); }
    f32x4 acco = (f32x4){0.f, 0.f, 0.f, 0.f};
#pragma unroll
    for (int ks = 0; ks < 4; ++ks) { const bf16x8 stf = *(const bf16x8*)(STr + (16 * jbo + fr) * 272 + (32 * ks + 8 * fq) * 2), qf = *(const bf16x8*)(buf + SC_QB + (16 * tb + fr) * 272 + (32 * ks + 8 * fq) * 2);
        acco = __builtin_amdgcn_mfma_f32_16x16x32_bf16(stf, qf, acco, 0, 0, 0); }
#pragma unroll
    for (int ks = 0; ks < 2; ++ks) if (2 * ks <= tb) { const bf16x8 af = *(const bf16x8*)(buf + SC_ATT + (16 * tb + fr) * 144 + (32 * ks + 8 * fq) * 2);
        acco = __builtin_amdgcn_mfma_f32_16x16x32_bf16(jbo ? vf[1][ks] : vf[0][ks], af, acco, 0, 0, 0); }
    { u32x2 w; w.x = cvt_pk_bf16(acco[0], acco[1]); w.y = cvt_pk_bf16(acco[2], acco[3]);
      const int ln = fr + 16 * fq, src = ((ln >> 2) + 16 * (ln & 3)) * 4;
      w.x = (unsigned)__builtin_amdgcn_ds_bpermute(src, (int)w.x); w.y = (unsigned)__builtin_amdgcn_ds_bpermute(src, (int)w.y);
      *(u32x2*)(OB + (size_t)(row0 + 16 * tb + (ln >> 2)) * DM + 256 * h + 32 * vs + 16 * jbo + 4 * (ln & 3)) = w; }
#pragma unroll
    for (int jb = 0; jb < 2; ++jb) { accS[jb] = accS[jb] * dl;
#pragma unroll
        for (int ks = 0; ks < 2; ++ks) accS[jb] = __builtin_amdgcn_mfma_f32_16x16x32_bf16(kdf[ks], vf[jb][ks], accS[jb], 0, 0, 0);
        u32x2 w; w.x = cvt_pk_bf16(accS[jb][0], accS[jb][1]); w.y = cvt_pk_bf16(accS[jb][2], accS[jb][3]);
        *(u32x2*)(STw + (16 * jb + fr) * 272 + (16 * kcb + 4 * fq) * 2) = w; }
    if (do_write) scan_stage_write(wr, nbuf, tid);
    __syncthreads();
}
__device__ __forceinline__ void gla_scan_phase(const Params& p, unsigned char* lds) {
    const int tid = tidx(), lane = tid & 63, wave = tid >> 6, fr = lane & 15, fq = lane >> 4;
    bf16_t* OB = (bf16_t*)(p.ws + WS_HB);
    unsigned char* ST = lds + SC_ST; unsigned char* ST2 = lds + SC_ST + 8704; unsigned char* B0 = lds + SC_BUF0; unsigned char* B1 = lds + SC_BUF0 + SC_BUFSZ;
    const int tb = wave >> 1, jbo = wave & 1, kcb = wave;
    const bool xaff = xloc();
    for (int lu = xaff ? xidx() : vbid(); lu < (xaff ? 32 : 256); lu += xaff ? xper() : (int)gridDim.x) {
        const int u = xaff ? xcls() * 32 + lu : lu;
        const int vs = u & 7, h = (u >> 3) & 3, b = u >> 5;
        const int pu0 = (b * 4 + h) * 32, r0 = b * SEQ;
        __syncthreads();
        for (int i = tid; i < 32 * 272 / 4; i += 512) ((unsigned*)ST)[i] = 0u;
        f32x4 accS[2] = {(f32x4){0.f, 0.f, 0.f, 0.f}, (f32x4){0.f, 0.f, 0.f, 0.f}};
        ScanStage Ra, Rb;
        scan_stage_load(Ra, p, pu0, r0, h, vs, kcb, fq, tid); scan_stage_load(Rb, p, pu0 + 1, r0 + 64, h, vs, kcb, fq, tid);
        scan_stage_write(Ra, B0, tid);
        f32x4 dl_cur = Ra.dl;
        __syncthreads();
        for (int c = 0; c < 32; c += 2) {
            { const int cn = c + 2 < 32 ? c + 2 : 31; scan_stage_load(Ra, p, pu0 + cn, r0 + 64 * cn, h, vs, kcb, fq, tid); }
            const f32x4 dl_odd = Rb.dl;
            scan_step(B0, dl_cur, accS, ST, ST2, OB, Rb, true, B1, r0 + 64 * c, h, vs, tb, jbo, kcb, fr, fq, tid);
            { const int cn = c + 3 < 32 ? c + 3 : 31; scan_stage_load(Rb, p, pu0 + cn, r0 + 64 * cn, h, vs, kcb, fq, tid); }
            dl_cur = Ra.dl;
            scan_step(B1, dl_odd, accS, ST2, ST, OB, Ra, c + 2 < 32, B0, r0 + 64 * (c + 1), h, vs, tb, jbo, kcb, fr, fq, tid);
        }
#pragma unroll
        for (int jb = 0; jb < 2; ++jb)
#pragma unroll
            for (int i = 0; i < 4; ++i) p.out[O_STP + ((size_t)(b * 4 + h) * 128 + 16 * kcb + 4 * fq + i) * 256 + 32 * vs + 16 * jb + fr] = accS[jb][i];
    }
}

__device__ __forceinline__ void gla_gate_phase(const Params& p) {
    const int lane = tidx() & 63, wave = tidx() >> 6;
    bf16_t* OB = (bf16_t*)(p.ws + WS_HB); const bf16_t* QKVG = (const bf16_t*)(p.ws + WS_R1);
    const f32x4 gn = *(const f32x4*)(p.gla_out_norm_g + 4 * lane);
    const bool xaff = xloc();
    const int nrl = xaff ? SEQ + (xidx() * 8 + wave < 16 ? 1 : 0) : MTOT;
    for (int rl = xaff ? xidx() * 8 + wave : (int)vbid() * 8 + wave; rl < nrl; rl += (xaff && rl < SEQ && rl + xper() * 8 >= SEQ) ? SEQ - rl : (xaff ? xper() * 8 : (int)gridDim.x * 8)) {
        const int row = xaff ? (rl < SEQ ? xcls() * SEQ + rl : MPR + 16 * xcls() + xidx() * 8 + wave) : rl;
#pragma unroll
        for (int j = 0; j < 4; ++j) {
            const u32x2 ow = *(const u32x2*)(OB + (size_t)row * DM + 256 * j + 4 * lane), gw = *(const u32x2*)(QKVG + (size_t)row * 3072 + 2048 + 256 * j + 4 * lane);
            const f32x4 o = (f32x4){__uint_as_float(ow.x << 16), __uint_as_float(ow.x & 0xffff0000u), __uint_as_float(ow.y << 16), __uint_as_float(ow.y & 0xffff0000u)};
            const f32x4 g = (f32x4){__uint_as_float(gw.x << 16), __uint_as_float(gw.x & 0xffff0000u), __uint_as_float(gw.y << 16), __uint_as_float(gw.y & 0xffff0000u)};
            const float rs = rsqrtf(wave_sum((o[0] * o[0] + o[1] * o[1]) + (o[2] * o[2] + o[3] * o[3])) * (1.0f / 256.0f) + EPSN);
            u32x2 w; w.x = cvt_pk_bf16(o[0] * rs * gn[0] * silu_f(g[0]), o[1] * rs * gn[1] * silu_f(g[1])); w.y = cvt_pk_bf16(o[2] * rs * gn[2] * silu_f(g[2]), o[3] * rs * gn[3] * silu_f(g[3]));
            *(u32x2*)(OB + (size_t)row * DM + 256 * j + 4 * lane) = w;
        }
    }
}


struct SEpiStore { bf16_t* O; int ldc;
    __device__ __forceinline__ void operator()(int row, int col, const f32x4 (&v)[4]) const {
        u32x4 w; w.x = cvt_pk_bf16(v[0][0], v[0][1]); w.y = cvt_pk_bf16(v[0][2], v[0][3]); w.z = cvt_pk_bf16(v[1][0], v[1][1]); w.w = cvt_pk_bf16(v[1][2], v[1][3]);
        *(u32x4*)(O + (size_t)row * ldc + col) = w; } };
struct SEpiSwiglu { bf16_t* O;
    __device__ __forceinline__ void operator()(int row, int col, const f32x4 (&v)[4]) const {
        u32x4 w; w.x = cvt_pk_bf16(silu_f(v[0][0]) * v[2][0], silu_f(v[0][1]) * v[2][1]); w.y = cvt_pk_bf16(silu_f(v[0][2]) * v[2][2], silu_f(v[0][3]) * v[2][3]);
        w.z = cvt_pk_bf16(silu_f(v[1][0]) * v[3][0], silu_f(v[1][1]) * v[3][1]); w.w = cvt_pk_bf16(silu_f(v[1][2]) * v[3][2], silu_f(v[1][3]) * v[3][3]);
        *(u32x4*)(O + (size_t)row * DFF + col) = w; } };
struct SEpiSgIn { bf16_t* U; bf16_t* V; float* stats_s;
    __device__ __forceinline__ void operator()(int row, int col, const f32x4 (&v)[4]) const {
        const pg8::f32x2 a = pg8::gelu_pk((pg8::f32x2){v[0][0], v[0][1]}), b = pg8::gelu_pk((pg8::f32x2){v[0][2], v[0][3]}), c = pg8::gelu_pk((pg8::f32x2){v[1][0], v[1][1]}), d = pg8::gelu_pk((pg8::f32x2){v[1][2], v[1][3]});
        u32x4 w; w.x = cvt_pk_bf16(a.x, a.y); w.y = cvt_pk_bf16(b.x, b.y); w.z = cvt_pk_bf16(c.x, c.y); w.w = cvt_pk_bf16(d.x, d.y);
        const bool isv = col >= 2048;
        *(u32x4*)((isv ? V : U) + (size_t)row * 2048 + (col & 2047)) = w;
        float s = (a.x + a.y) + (b.x + b.y) + (c.x + c.y) + (d.x + d.y), q = (a.x * a.x + a.y * a.y) + (b.x * b.x + b.y * b.y) + (c.x * c.x + c.y * c.y) + (d.x * d.x + d.y * d.y);
        s += __shfl_xor(s, 16); s += __shfl_xor(s, 32); q += __shfl_xor(q, 16); q += __shfl_xor(q, 32);
        if (isv && (tidx() & 48) == 0) *(pg8::f32x2*)(stats_s + ((size_t)(row - MPR) * 64 + ((col - 2048) >> 5)) * 2) = (pg8::f32x2){s, q}; } };

template <int NB, int KS, int NIT, int UB, class SEpi>
__device__ __forceinline__ void skinny_gemm(unsigned char* lds, const bf16_t* __restrict__ A, const bf16_t* __restrict__ Bt, int N, int K, bool w13map, const SEpi& E, int skip_first = 0) {
    static_assert(NIT % UB == 0 && (8 % KS) == 0, "bad skinny shape");
    const int lane = tidx() & 63, wave = tidx() >> 6, fr = lane & 15, fq = lane >> 4;
    constexpr int TPW = 8 / KS;
    const int ntasks = (N / 32) * 8 / TPW;
    const int split = wave % KS, tl = wave / KS;
    f32x4* red = (f32x4*)lds;
    const bool xaff = xloc();
    if (xaff && xidx() < skip_first) return;
    for (int wt = xaff ? xidx() - skip_first : vbid(); wt < (xaff ? (N / 32) / TPW : ntasks); wt += xaff ? xper() - skip_first : (int)gridDim.x) {
        const int t = wt * TPW + tl, cg = xaff ? t : t >> 3, rb = xaff ? xcls() : t & 7;
        const int wb = w13map ? 256 * (cg >> 2) + 32 * (cg & 3) : 32 * cg;
        const int lr = lane >> 2;
        const bf16_t* ap = A + (size_t)(MPR + 16 * rb + lr) * K + (size_t)split * NIT * 32 + 8 * (lane & 3);
        const bf16_t* bp = Bt + (size_t)(wb + 8 * (lr >> 2) + (lr & 3)) * K + (size_t)split * NIT * 32 + 8 * (lane & 3);
        f32x4 acc[NB * 2];
#pragma unroll
        for (int i = 0; i < NB * 2; ++i) acc[i] = (f32x4){0.f, 0.f, 0.f, 0.f};
        for (int k0 = 0; k0 < NIT; k0 += UB) {
            u32x4 af[UB], bfv[UB][NB * 2];
#pragma unroll
            for (int u = 0; u < UB; ++u) { af[u] = *(const u32x4*)(ap + (k0 + u) * 32);
#pragma unroll
                for (int g = 0; g < NB; ++g)
#pragma unroll
                    for (int n = 0; n < 2; ++n) bfv[u][g * 2 + n] = *(const u32x4*)(bp + (size_t)(128 * g + 4 * n) * K + (k0 + u) * 32); }
#pragma unroll
            for (int u = 0; u < UB; ++u) { const bf16x8 a = frag_perm(af[u], lane);
#pragma unroll
                for (int i = 0; i < NB * 2; ++i) acc[i] = __builtin_amdgcn_mfma_f32_16x16x32_bf16(frag_perm(bfv[u][i], lane), a, acc[i], 0, 0, 0); }
        }
        if (KS > 1) {
            __syncthreads();
#pragma unroll
            for (int i = 0; i < NB * 2; ++i) red[(wave * NB * 2 + i) * 64 + lane] = acc[i];
            __syncthreads();
            if (split == 0) {
#pragma unroll
                for (int sp = 1; sp < KS; ++sp)
#pragma unroll
                    for (int i = 0; i < NB * 2; ++i) acc[i] = acc[i] + red[((wave + sp) * NB * 2 + i) * 64 + lane];
            }
        }
        if (split == 0) {
            f32x4 v[4];
#pragma unroll
            for (int i = 0; i < 4; ++i) v[i] = acc[i < NB * 2 ? i : 0];
            E(MPR + 16 * rb + fr, 32 * cg + 8 * fq, v);
        }
    }
}

#define LAS __attribute__((address_space(3)))
#define XB_TMO      128
#define XB_XCNT(j)  (256  + 64 * (j))
#define XB_XSUB(j)  (1280 + 64 * (j))
#define XB_XGEN(j)  (2304 + 64 * (j))
#define XB_TOP      3328
#define XB_TOPGEN   3392
#define XCD_BAR_WORDS 3456
#define XB_SPIN_CAP (1u << 18)

__device__ __forceinline__ unsigned xb_ld(unsigned* p)              { return __hip_atomic_load(p, __ATOMIC_RELAXED, __HIP_MEMORY_SCOPE_AGENT); }
__device__ __forceinline__ unsigned xb_add(unsigned* p, unsigned v) { return __hip_atomic_fetch_add(p, v, __ATOMIC_RELAXED, __HIP_MEMORY_SCOPE_AGENT); }
__device__ __forceinline__ unsigned xb_xcc_id() { return (unsigned)__builtin_amdgcn_s_getreg((3 << 11) | 20) & 0xFu; }
#define XB_SPIN(cond, bar) do { unsigned _sp = 0; while (cond) { __builtin_amdgcn_s_sleep(1); \
    if ((++_sp & 255u) == 0u) { if (xb_ld(&(bar)[XB_TMO])) break; if (_sp > XB_SPIN_CAP) { atomicAdd(&(bar)[XB_TMO], 1u); break; } } } } while (0)

struct XcdBarrier {
    unsigned* bar; unsigned x;
    volatile LAS unsigned* st;
};

__device__ __forceinline__ XcdBarrier xcd_barrier_post(unsigned* bar, volatile LAS unsigned* st) {
    XcdBarrier b; b.bar = bar; b.x = xb_xcc_id(); b.st = st;
    if (threadIdx.x == 0) (void)xb_add(&bar[XB_XCNT(b.x)], 1u);
    return b;
}
__device__ __forceinline__ void xcd_barrier_complete(unsigned* bar, unsigned x, unsigned& nloc, unsigned& nx) {
    const unsigned G = gridDim.x * gridDim.y * gridDim.z;
    unsigned sum, cnt, mine, sp = 0u;
    for (;;) {
        sum = 0u; cnt = 0u; mine = 0u;
#pragma unroll
        for (unsigned j = 0; j < 16; ++j) { const unsigned c = xb_ld(&bar[XB_XCNT(j)]); sum += c; cnt += (c > 0u) ? 1u : 0u; mine = (j == x) ? c : mine; }
        if (sum == G) break;
        __builtin_amdgcn_s_sleep(1);
        if ((++sp & 255u) == 0u) { if (xb_ld(&bar[XB_TMO])) break; if (sp > XB_SPIN_CAP) { atomicAdd(&bar[XB_TMO], 1u); break; } }
    }
    nloc = mine > 0u ? mine : 1u; nx = cnt > 0u ? cnt : 1u;
}

__device__ __forceinline__ void xcd_barrier(const XcdBarrier& b) {
    asm volatile("s_waitcnt vmcnt(0)" ::: "memory");
    __syncthreads();
    if (threadIdx.x == 0) {
        unsigned* bar = b.bar;
        __builtin_amdgcn_s_waitcnt(0);
        unsigned nloc = b.st[0], nx = b.st[1];
        if (nloc == 0u) { xcd_barrier_complete(bar, b.x, nloc, nx); b.st[0] = nloc; b.st[1] = nx; }
        const unsigned old = xb_add(&bar[XB_XSUB(b.x)], 1u);
        const unsigned gen = old / nloc;
        if (old + 1u == (gen + 1u) * nloc) {
            __builtin_amdgcn_fence(__ATOMIC_RELEASE, "agent");
            asm volatile("s_waitcnt vmcnt(0)" ::: "memory");
            const unsigned og = xb_add(&bar[XB_TOP], 1u);
            const unsigned tg = og / nx;
            if (og + 1u == (tg + 1u) * nx) xb_add(&bar[XB_TOPGEN], 1u);
            else XB_SPIN(xb_ld(&bar[XB_TOPGEN]) == tg, bar);
            __builtin_amdgcn_fence(__ATOMIC_ACQUIRE, "agent");
            xb_add(&bar[XB_XGEN(b.x)], 1u);
            asm volatile("s_waitcnt vmcnt(0)" ::: "memory");
        } else {
            XB_SPIN(xb_ld(&bar[XB_XGEN(b.x)]) == gen, bar);
            __builtin_amdgcn_fence(__ATOMIC_ACQUIRE, "agent");
            asm volatile("s_waitcnt vmcnt(0)" ::: "memory");
        }
    }
    __syncthreads();
}

__device__ __forceinline__ void xcc_barrier(const XcdBarrier& b) {
    asm volatile("s_waitcnt vmcnt(0)" ::: "memory");
    __syncthreads();
    if (threadIdx.x == 0) {
        unsigned* bar = b.bar; unsigned* cnt = bar + 4096 + 64 * b.x;
        const unsigned k = b.st[6], nloc = b.st[0]; b.st[6] = k + 1u;
        const unsigned target = (k + 1u) * nloc;
        (void)xb_add(cnt, 1u);
        XB_SPIN(xb_ld(cnt) < target, bar);
        __builtin_amdgcn_fence(__ATOMIC_ACQUIRE, "agent");
        asm volatile("s_waitcnt vmcnt(0)" ::: "memory");
    }
    __syncthreads();
}
#define gsync(g) xcd_barrier(xb)
#define lsync(g) do { if (xloc()) xcc_barrier(xb); else xcd_barrier(xb); } while (0)
template <class Epi> __device__ __forceinline__ void run_gemm(unsigned char* lds, const bf16_t* A, const bf16_t* Bt, int N, int K, const Epi& E) {
    pg8::Gemm g; g.A = A; g.Bt = Bt; g.M = MPR; g.N = N; g.K = K;
    pg8::StaticOrder S; S.init(MPR, N, (int)gridDim.x, vbid());
    pg8::gemm_phase<Epi, pg8::StaticOrder, false>((PG8_LAS unsigned char*)lds, g, S, E, nullptr);
}

__global__ void __launch_bounds__(512, 2) fwd_megakernel(Params p) {
    extern __shared__ __attribute__((aligned(16))) unsigned char shm[];
    cg::grid_group grid = cg::this_grid();
    unsigned char* ws = p.ws;
    bf16_t* HB = (bf16_t*)(ws + WS_HB); bf16_t* UB = (bf16_t*)(ws + WS_R1); bf16_t* VB = UB + (size_t)MP * 2048; bf16_t* MB = (bf16_t*)(ws + WS_MBUF);
    bf16_t* ACT = (bf16_t*)(ws + WS_R1); bf16_t* QKVG = (bf16_t*)(ws + WS_R1);
    const float* ng = p.norm_g;
    volatile LAS unsigned* xst = (volatile LAS unsigned*)(LAS unsigned char*)(shm + 131072);
    if (tidx() < 8) xst[tidx()] = 0u;
    __syncthreads();
    const XcdBarrier xb = xcd_barrier_post((unsigned*)(ws + WS_BAR), xst);
    unsigned my_wi = 0u;
    if (tidx() == 0) { my_wi = xb_add((unsigned*)(ws + WS_BAR) + 3520 + 64 * (xb.x & 7u), 1u); xst[4] = blockIdx.x; }
    if (p.ws == nullptr) grid.sync();
    __syncthreads();
    phase0(p, shm);
    gsync(grid);
    if (tidx() == 0) { bool ok = (gridDim.x & 7u) == 0u && xb.x < 8u;
        for (unsigned j = 0; j < 16; ++j) { const unsigned c = xb_ld((unsigned*)(ws + WS_BAR) + XB_XCNT(j)); ok = ok && (c == (j < 8u ? (gridDim.x >> 3) : 0u)); }
        if (ok) { xst[4] = my_wi * 8u + xb.x; xst[5] = 1u; } }
    __syncthreads();
    { pg8::EpiSgIn E; E.U = UB; E.V = VB; E.stats = (float*)(ws + WS_STATS); run_gemm(shm, HB, (const bf16_t*)(ws + W_SGIN), 4096, 1024, E);
      SEpiSgIn SE; SE.U = UB; SE.V = VB; SE.stats_s = (float*)(ws + WS_STATS_S); skinny_gemm<1, 2, 16, 8>(shm, HB, (const bf16_t*)(ws + W_SGIN), 4096, 1024, false, SE); }
    lsync(grid);
    sgu_phase(p, shm);
    lsync(grid);
    { pg8::EpiStoreBf16 E; E.O = MB; E.ldc = 1024; run_gemm(shm, UB, (const bf16_t*)(ws + W_SGOUT), 1024, 2048, E);
      SEpiStore SE; SE.O = MB; SE.ldc = 1024; skinny_gemm<1, 8, 8, 8>(shm, UB, (const bf16_t*)(ws + W_SGOUT), 1024, 2048, false, SE); }
    lsync(grid);
    norm_phase(p, 1, ng + 1 * DM, ng + 2 * DM, true);
    lsync(grid);
    { pg8::EpiSwiglu E; E.O = ACT; run_gemm(shm, HB, (const bf16_t*)(ws + W_13_0), 5632, 1024, E);
      SEpiSwiglu SE; SE.O = ACT; skinny_gemm<2, 2, 16, 4>(shm, HB, (const bf16_t*)(ws + W_13_0), 2816, 1024, true, SE);
      const int nu = 64 * 22, rem = nu % (int)gridDim.x;
      if (rem == 0) convert_weights(p, shm, true, vbid() * 8 + (tidx() >> 6), (int)gridDim.x * 8);
      else if (vbid() >= rem) convert_weights(p, shm, true, (vbid() - rem) * 8 + (tidx() >> 6), ((int)gridDim.x - rem) * 8); }
    lsync(grid);
    { pg8::EpiStoreBf16 E; E.O = MB; E.ldc = 1024; run_gemm(shm, ACT, (const bf16_t*)(ws + W_2_0), 1024, 2816, E);
      SEpiStore SE; SE.O = MB; SE.ldc = 1024; skinny_gemm<1, 8, 11, 11>(shm, ACT, (const bf16_t*)(ws + W_2_0), 1024, 2816, false, SE); }
    lsync(grid);
    norm_phase(p, 1, ng + 3 * DM, ng + 4 * DM, false);
    lsync(grid);
    { pg8::EpiStoreBf16 E; E.O = QKVG; E.ldc = 3072; run_gemm(shm, HB, (const bf16_t*)(ws + W_GLAIN), 3072, 1024, E);
      SEpiStore SE; SE.O = QKVG; SE.ldc = 3072; skinny_gemm<1, 2, 16, 8>(shm, HB, (const bf16_t*)(ws + W_GLAIN), 3072, 1024, false, SE); }
    gla_r_tasks(p);
    lsync(grid);
    gla_prep_phase(p, shm);
    lsync(grid);
    gla_scan_phase(p, shm);
    lsync(grid);
    gla_gate_phase(p);
    lsync(grid);
    { pg8::EpiStoreBf16 E; E.O = MB; E.ldc = 1024; run_gemm(shm, HB, (const bf16_t*)(ws + W_GLAOUT), 1024, 1024, E);
      SEpiStore SE; SE.O = MB; SE.ldc = 1024; skinny_gemm<1, 8, 4, 4>(shm, HB, (const bf16_t*)(ws + W_GLAOUT), 1024, 1024, false, SE); }
    gsync(grid);
    norm_phase(p, 1, ng + 5 * DM, ng + 6 * DM, false);
    lsync(grid);
    { pg8::EpiSwiglu E; E.O = ACT; run_gemm(shm, HB, (const bf16_t*)(ws + W_13_1), 5632, 1024, E);
      SEpiSwiglu SE; SE.O = ACT; skinny_gemm<2, 2, 16, 4>(shm, HB, (const bf16_t*)(ws + W_13_1), 2816, 1024, true, SE, (64 * 22 % (int)gridDim.x) / 8); }
    lsync(grid);
    { pg8::EpiStoreBf16 E; E.O = MB; E.ldc = 1024; run_gemm(shm, ACT, (const bf16_t*)(ws + W_2_1), 1024, 2816, E);
      SEpiStore SE; SE.O = MB; SE.ldc = 1024; skinny_gemm<1, 8, 11, 11>(shm, ACT, (const bf16_t*)(ws + W_2_1), 1024, 2816, false, SE); }
    lsync(grid);
    norm_phase(p, 2, ng + 7 * DM, nullptr, false);
}

extern "C" void kernel_launch(void* const* d_in, const int* in_sizes, int n_in, void* d_out, int out_size, void* d_ws, size_t ws_size, hipStream_t stream) {
    static int grid_blocks = 0;
    if (!grid_blocks) {
        if (n_in != 17 || ws_size < WS_END) { fprintf(stderr, "kernel_launch: unexpected n_in %d or ws_size %zu (< %zu)\n", n_in, ws_size, (size_t)WS_END); grid_blocks = -1; return; }
        int dev = 0, cus = 0, per_cu = 0;
        hipGetDevice(&dev);
        hipDeviceGetAttribute(&cus, hipDeviceAttributeMultiprocessorCount, dev);
        hipFuncSetAttribute((const void*)fwd_megakernel, hipFuncAttributeMaxDynamicSharedMemorySize, LDS_BYTES);
        hipOccupancyMaxActiveBlocksPerMultiprocessor(&per_cu, (const void*)fwd_megakernel, 512, LDS_BYTES);
        if (per_cu < 1) { fprintf(stderr, "kernel_launch: occupancy query returned %d\n", per_cu); per_cu = 1; }
        grid_blocks = cus * per_cu;
    }
    if (grid_blocks < 0) return;
    Params p{};
    p.x_prompt = (const float*)d_in[0]; p.x_sample = (const float*)d_in[1]; p.state_gla = (const float*)d_in[2]; p.norm_g = (const float*)d_in[3];
    p.ffn_w13 = (const float*)d_in[4]; p.ffn_w2 = (const float*)d_in[5]; p.sg_w_in = (const float*)d_in[6]; p.sg_ln_g = (const float*)d_in[7]; p.sg_ln_b = (const float*)d_in[8];
    p.sg_w_s = (const float*)d_in[9]; p.sg_b_s = (const float*)d_in[10]; p.sg_w_out = (const float*)d_in[11]; p.gla_w_in = (const float*)d_in[12];
    p.gla_w_gate_up = (const float*)d_in[13]; p.gla_b_gate = (const float*)d_in[14]; p.gla_out_norm_g = (const float*)d_in[15]; p.gla_w_out = (const float*)d_in[16];
    p.out = (float*)d_out; p.ws = (unsigned char*)d_ws;
    if (hipMemsetAsync((char*)d_ws + WS_BAR, 0, 32768, stream) != hipSuccess) { fprintf(stderr, "kernel_launch: memset of the barrier words failed\n"); return; }
    void* args[] = {&p};
    hipError_t e = hipLaunchCooperativeKernel((const void*)fwd_megakernel, dim3(grid_blocks), dim3(512), args, LDS_BYTES, stream);
    if (e != hipSuccess) fprintf(stderr, "cooperative launch failed: %s (grid %d)\n", hipGetErrorString(e), grid_blocks);
}
```

```cpp
#include <hip/hip_runtime.h>
#include <hip/hip_cooperative_groups.h>
#include <cstdio>
namespace cg = cooperative_groups;
__device__ __forceinline__ int tidx() { int t = (int)threadIdx.x; asm volatile("" : "+v"(t)); return t; }

namespace pg8 {
#define PG8_LAS __attribute__((address_space(3)))
typedef unsigned short bf16_t;
typedef short bf16x8 __attribute__((ext_vector_type(8)));
typedef float f32x4 __attribute__((ext_vector_type(4)));
typedef unsigned u32x4 __attribute__((ext_vector_type(4)));
constexpr int BM = 256, BK = 64, HALF = 128, HTB = HALF * BK * 2  , STAGE_BYTES = 8 * HTB, NXCD = 8, WGM = 8;

__host__ __device__ __forceinline__ int lds_byte(int r, int c) { const int st = (r >> 4) * 2 + (c >> 5), rr = r & 15, cc = c & 31, ob = rr * 64 + cc * 2; return st * 1024 + (ob ^ (((ob >> 9) & 1) << 5)); }
__host__ __device__ __forceinline__ void stage_rc(int b, int& R, int& C) { const int st = b / 1024, sb = b % 1024, swz = sb ^ (((sb >> 9) & 1) << 5); R = (st >> 1) * 16 + swz / 64; C = (st & 1) * 32 + (swz % 64) / 2; }
__host__ __device__ __forceinline__ int perm32(int rho) { const int n = rho >> 4, i = rho & 15; return 8 * (i >> 2) + 4 * n + (i & 3); }

struct Unit { int pm, pn; };
struct Gemm { const bf16_t* A; const bf16_t* Bt; int M, N, K; };

struct StaticOrder {
    int nM, nN, nwg, G, c;
    __host__ __device__ void init(int M, int N, int G_, int c_) { nM = M / BM; nN = N / BM; nwg = nM * nN; G = G_; c = c_; }
    __host__ __device__ bool next(int i, Unit& u) const {
        const long L = (long)i * G + c; if (L >= nwg) return false;
        int wgid = (int)L; { const int q = nwg / NXCD, r = nwg % NXCD, xcd = wgid % NXCD, off = wgid / NXCD; wgid = (xcd < r ? xcd * (q + 1) : r * (q + 1) + (xcd - r) * q) + off; }
        const int nig = WGM * nN, gid = wgid / nig, fm = gid * WGM, gsz = (nM - fm) < WGM ? (nM - fm) : WGM;
        u.pm = fm + ((wgid % nig) % gsz); u.pn = (wgid % nig) / gsz; return true;
    }
    __device__ __forceinline__ void a_ready(const Unit&) const {}
    __device__ __forceinline__ void done(const Unit&) const {}
};
typedef __bf16 bf16x2v_t __attribute__((ext_vector_type(2)));
__device__ __forceinline__ unsigned cvt_pk_bf16(float lo, float hi) { typedef float f2_t __attribute__((ext_vector_type(2))); const f2_t v = {lo, hi}; const bf16x2v_t r = __builtin_convertvector(v, bf16x2v_t); return __builtin_bit_cast(unsigned, r); }
typedef float f32x2 __attribute__((ext_vector_type(2)));
__device__ __forceinline__ f32x2 gelu_pk(f32x2 v) {
    const f32x2 av = __builtin_elementwise_abs(v), d = av * 0.2316418882f + 1.0f;
    f32x2 t; t.x = __builtin_amdgcn_rcpf(d.x); t.y = __builtin_amdgcn_rcpf(d.y);
    f32x2 q = t * 0.5307027145f + (-0.7265760135f); q = q * t + 0.7107068705f; q = q * t + (-0.142248368f); q = q * t + 0.127414796f; q = q * t;
    const f32x2 s = (v * v) * (-0.72134752044f);
    f32x2 e; e.x = __builtin_amdgcn_exp2f(s.x); e.y = __builtin_amdgcn_exp2f(s.y);
    const f32x2 m = v * (q * e), r = v - m;
    f32x2 o; o.x = v.x < 0.f ? m.x : r.x; o.y = v.y < 0.f ? m.y : r.y; return o;
}
typedef unsigned long long u64_t;
__device__ __forceinline__ u32x4 quad_rows(const u32x4 w, int lane) {
    const int src = ((lane >> 2) + 16 * (lane & 3)) * 4; u32x4 r;
    r.x = (unsigned)__builtin_amdgcn_ds_bpermute(src, (int)w.x); r.y = (unsigned)__builtin_amdgcn_ds_bpermute(src, (int)w.y);
    r.z = (unsigned)__builtin_amdgcn_ds_bpermute(src, (int)w.z); r.w = (unsigned)__builtin_amdgcn_ds_bpermute(src, (int)w.w); return r; }
__device__ __forceinline__ float bf2f(unsigned short b) { return __uint_as_float(((unsigned)b) << 16); }
__device__ __forceinline__ float silu_f(float x) { return x * __builtin_amdgcn_rcpf(1.0f + __expf(-x)); }

struct EpiStoreBf16 {
    static constexpr bool PERM = true, AFTER_DRAIN = false;
    bf16_t* O; int ldc;
    __device__ __forceinline__ void operator()(const f32x4 (&acc)[2][2][4][2], const Unit& u, int wr, int wc, int fr, int fq) const {
        const int lane = fr + 16 * fq, row0 = u.pm * BM + wr * 64 + (lane >> 2), col0 = u.pn * BM + wc * 32 + 8 * (lane & 3);
#pragma unroll
        for (int ai = 0; ai < 2; ++ai)
#pragma unroll
            for (int m = 0; m < 4; ++m) { bf16_t* rowp = O + (size_t)(row0 + ai * HALF + m * 16) * ldc + col0;
#pragma unroll
                for (int bj = 0; bj < 2; ++bj) { const f32x4 v0 = acc[ai][bj][m][0], v1 = acc[ai][bj][m][1];
                    u32x4 w; w.x = cvt_pk_bf16(v0[0], v0[1]); w.y = cvt_pk_bf16(v0[2], v0[3]); w.z = cvt_pk_bf16(v1[0], v1[1]); w.w = cvt_pk_bf16(v1[2], v1[3]);
                    *(u32x4*)(rowp + bj * HALF) = quad_rows(w, lane); } }
    }
};
struct EpiSgIn {
    static constexpr bool PERM = true, AFTER_DRAIN = false;
    bf16_t* U; bf16_t* V; float* stats;
    __device__ __forceinline__ void operator()(const f32x4 (&acc)[2][2][4][2], const Unit& u, int wr, int wc, int fr, int fq) const {
        const bool isv = u.pn >= 8; bf16_t* base = isv ? V : U;
        const int lane = fr + 16 * fq, row0 = u.pm * BM + wr * 64 + fr, rowq = u.pm * BM + wr * 64 + (lane >> 2), col0 = (u.pn & 7) * BM + wc * 32 + 8 * (lane & 3);
#pragma unroll
        for (int ai = 0; ai < 2; ++ai)
#pragma unroll
            for (int m = 0; m < 4; ++m) { const int row = row0 + ai * HALF + m * 16; bf16_t* rowp = base + (size_t)(rowq + ai * HALF + m * 16) * 2048 + col0; float s = 0.f, q = 0.f;
#pragma unroll
                for (int bj = 0; bj < 2; ++bj) { f32x4 v0 = acc[ai][bj][m][0], v1 = acc[ai][bj][m][1];
                    f32x2 a = gelu_pk((f32x2){v0[0], v0[1]}), b = gelu_pk((f32x2){v0[2], v0[3]}), c = gelu_pk((f32x2){v1[0], v1[1]}), d = gelu_pk((f32x2){v1[2], v1[3]});
                    s += (a.x + a.y) + (b.x + b.y) + (c.x + c.y) + (d.x + d.y);
                    q += (a.x * a.x + a.y * a.y) + (b.x * b.x + b.y * b.y) + (c.x * c.x + c.y * c.y) + (d.x * d.x + d.y * d.y);
                    u32x4 w; w.x = cvt_pk_bf16(a.x, a.y); w.y = cvt_pk_bf16(b.x, b.y); w.z = cvt_pk_bf16(c.x, c.y); w.w = cvt_pk_bf16(d.x, d.y);
                    *(u32x4*)(rowp + bj * HALF) = quad_rows(w, lane); }
                if (isv) { s += __shfl_xor(s, 16); s += __shfl_xor(s, 32); q += __shfl_xor(q, 16); q += __shfl_xor(q, 32);
                    if (fq == 0) *(f32x2*)(stats + ((size_t)row * 32 + (u.pn - 8) * 4 + wc) * 2) = (f32x2){s, q}; } }
    }
};
struct EpiSwiglu {
    static constexpr bool PERM = true, AFTER_DRAIN = false;
    bf16_t* O;
    __device__ __forceinline__ void operator()(const f32x4 (&acc)[2][2][4][2], const Unit& u, int wr, int wc, int fr, int fq) const {
        const int lane = fr + 16 * fq, row0 = u.pm * BM + wr * 64 + (lane >> 2), col0 = u.pn * 128 + wc * 32 + 8 * (lane & 3);
#pragma unroll
        for (int ai = 0; ai < 2; ++ai)
#pragma unroll
            for (int m = 0; m < 4; ++m) { bf16_t* rowp = O + (size_t)(row0 + ai * HALF + m * 16) * 2816 + col0;
                const f32x4 a0 = acc[ai][0][m][0], a1 = acc[ai][0][m][1], b0 = acc[ai][1][m][0], b1 = acc[ai][1][m][1];
                u32x4 w; w.x = cvt_pk_bf16(silu_f(a0[0]) * b0[0], silu_f(a0[1]) * b0[1]); w.y = cvt_pk_bf16(silu_f(a0[2]) * b0[2], silu_f(a0[3]) * b0[3]);
                w.z = cvt_pk_bf16(silu_f(a1[0]) * b1[0], silu_f(a1[1]) * b1[1]); w.w = cvt_pk_bf16(silu_f(a1[2]) * b1[2], silu_f(a1[3]) * b1[3]);
                *(u32x4*)rowp = quad_rows(w, lane); }
    }
};

template <class Epi, class Sched, bool STAMP = false>
__device__ __forceinline__ void gemm_phase(PG8_LAS unsigned char* lds, const Gemm g, const Sched& S, const Epi& E, unsigned long long* stamps) {
    const int tid = tidx(), wid = __builtin_amdgcn_readfirstlane(tid >> 6), lane = tid & 63, wr = wid >> 2, wc = wid & 3, fr = lane & 15, fq = lane >> 4;
    const int K = g.K, nt = K / BK;
    int ts_lo = 0, ts_hi = 0, nts = 0; const unsigned long long rt_entry = STAMP ? (unsigned long long)wall_clock64() : 0ull;
#define PG8_STAMP() do { if (STAMP && wid == 0 && nts < 64) { const unsigned long long _c = (unsigned long long)clock64(); \
        ts_lo = (lane == nts) ? (int)(unsigned)_c : ts_lo; ts_hi = (lane == nts) ? (int)(unsigned)(_c >> 32) : ts_hi; ++nts; } } while (0)
    PG8_STAMP();
    unsigned voffA[2], voffB[2];
#pragma unroll
    for (int i = 0; i < 2; ++i) { int R, C; stage_rc(tid * 16 + i * 8192, R, C); const int Rb = Epi::PERM ? ((R & ~31) + perm32(R & 31)) : R;
        voffA[i] = (unsigned)(R * K + C) * 2u; voffB[i] = (unsigned)(Rb * K + C) * 2u; }
    const size_t kstep = (size_t)(BK * 2);
    const size_t hstep = (size_t)HALF * K * 2;
    const size_t tstep = 2 * hstep;
    const unsigned ldsw = (unsigned)wid * 1024u;
    const int aoff = lds_byte(wr * 64 + fr, fq * 8), boff = lds_byte(wc * 32 + fr, fq * 8);
#define PG8_SA(b, h) (((b) * 2 + (h)) * HTB)
#define PG8_SB(b, h) ((4 + (b) * 2 + (h)) * HTB)
#define PG8_STAGE(bufoff, gbase, voff) do { _Pragma("unroll") for (int _i = 0; _i < 2; ++_i) \
        __builtin_amdgcn_global_load_lds((const unsigned*)((const char*)(gbase) + (voff)[_i]), (PG8_LAS unsigned*)(lds + (bufoff) + ldsw + _i * 8192), 16, 0, 0); } while (0)
#define PG8_LDA(dst, b, h) do { _Pragma("unroll") for (int m = 0; m < 4; ++m) _Pragma("unroll") for (int k = 0; k < 2; ++k) dst[m][k] = *(const PG8_LAS bf16x8*)(lds + PG8_SA(b, h) + aoff + m * 2048 + k * 1024); } while (0)
#define PG8_LDB(dst, b, h) do { _Pragma("unroll") for (int n = 0; n < 2; ++n) _Pragma("unroll") for (int k = 0; k < 2; ++k) dst[n][k] = *(const PG8_LAS bf16x8*)(lds + PG8_SB(b, h) + boff + n * 2048 + k * 1024); } while (0)
#define PG8_MMA(ai, bj, At, Bt) do { __builtin_amdgcn_s_setprio(1); _Pragma("unroll") for (int m = 0; m < 4; ++m) _Pragma("unroll") for (int n = 0; n < 2; ++n) _Pragma("unroll") for (int k = 0; k < 2; ++k) \
        acc[ai][bj][m][n] = __builtin_amdgcn_mfma_f32_16x16x32_bf16(Bt[n][k], At[m][k], acc[ai][bj][m][n], 0, 0, 0); __builtin_amdgcn_s_setprio(0); } while (0)
#define PG8_WAIT_V(n) asm volatile("s_waitcnt vmcnt(" #n ")" ::: "memory")
#define PG8_WAIT_L(n) asm volatile("s_waitcnt lgkmcnt(" #n ")" ::: "memory")
#define PG8_BAR __builtin_amdgcn_s_barrier()
#define PG8_SCHED __builtin_amdgcn_sched_barrier(0)
    Unit cur, nxt; int ui = 0;
    if (!S.next(0, cur)) return;
    f32x4 acc[2][2][4][2];
#pragma unroll
    for (int a = 0; a < 2; ++a)
#pragma unroll
        for (int b = 0; b < 2; ++b)
#pragma unroll
            for (int m = 0; m < 4; ++m)
#pragma unroll
                for (int n = 0; n < 2; ++n) acc[a][b][m][n] = (f32x4){0.f, 0.f, 0.f, 0.f};
    bf16x8 At[4][2], B0[2][2], B1[2][2];
    const char* cA = (const char*)g.A + (size_t)cur.pm * tstep; const char* cB = (const char*)g.Bt + (size_t)cur.pn * tstep;
    S.a_ready(cur);
    PG8_STAGE(PG8_SB(0, 0), cB, voffB); PG8_STAGE(PG8_SA(0, 0), cA, voffA); PG8_STAGE(PG8_SB(0, 1), cB + hstep, voffB); PG8_STAGE(PG8_SA(0, 1), cA + hstep, voffA);
    if (wr == 1) PG8_BAR;
    PG8_WAIT_V(4); PG8_BAR;
    PG8_STAGE(PG8_SB(1, 0), cB + kstep, voffB); PG8_STAGE(PG8_SA(1, 0), cA + kstep, voffA); PG8_STAGE(PG8_SB(1, 1), cB + hstep + kstep, voffB);
    PG8_WAIT_V(6); PG8_BAR;
    PG8_STAMP();
    for (;;) {
        const bool has_next = S.next(ui + 1, nxt);
        const char* nA = has_next ? (const char*)g.A + (size_t)nxt.pm * tstep : cA; const char* nB = has_next ? (const char*)g.Bt + (size_t)nxt.pn * tstep : cB;
        for (int t = 0; t < nt; t += 2) {
            const bool last = (t == nt - 2);
            const char* a1 = cA + (size_t)(t + 1) * kstep;
            const char* a2 = last ? nA : cA + (size_t)(t + 2) * kstep; const char* b2 = last ? nB : cB + (size_t)(t + 2) * kstep;
            const char* a3 = a2 + kstep; const char* b3 = b2 + kstep;
            if (last && has_next) S.a_ready(nxt);
            PG8_LDB(B0, 0, 0); PG8_SCHED; PG8_LDA(At, 0, 0); PG8_STAGE(PG8_SA(1, 1), a1 + hstep, voffA);
            PG8_WAIT_L(8); PG8_BAR; PG8_WAIT_L(0); PG8_MMA(0, 0, At, B0); PG8_BAR; PG8_SCHED;
            PG8_LDB(B1, 0, 1); PG8_STAGE(PG8_SB(0, 0), b2, voffB);
            PG8_BAR; PG8_WAIT_L(0); PG8_MMA(0, 1, At, B1); PG8_BAR;
            PG8_LDA(At, 0, 1); PG8_STAGE(PG8_SA(0, 0), a2, voffA);
            PG8_BAR; PG8_WAIT_L(0); PG8_MMA(1, 0, At, B0); PG8_BAR; PG8_SCHED;
            PG8_STAGE(PG8_SB(0, 1), b2 + hstep, voffB);
            PG8_WAIT_V(6); PG8_BAR; PG8_MMA(1, 1, At, B1); PG8_BAR;
            PG8_LDB(B0, 1, 0); PG8_SCHED; PG8_LDA(At, 1, 0); PG8_STAGE(PG8_SA(0, 1), a2 + hstep, voffA);
            PG8_WAIT_L(8); PG8_BAR; PG8_WAIT_L(0); PG8_MMA(0, 0, At, B0); PG8_BAR; PG8_SCHED;
            PG8_LDB(B1, 1, 1); PG8_STAGE(PG8_SB(1, 0), b3, voffB);
            PG8_BAR; PG8_WAIT_L(0); PG8_MMA(0, 1, At, B1); PG8_BAR;
            PG8_LDA(At, 1, 1); PG8_STAGE(PG8_SA(1, 0), a3, voffA);
            PG8_BAR; PG8_WAIT_L(0); PG8_MMA(1, 0, At, B0); PG8_BAR; PG8_SCHED;
            PG8_STAGE(PG8_SB(1, 1), b3 + hstep, voffB);
            PG8_WAIT_V(6); PG8_BAR; PG8_MMA(1, 1, At, B1); PG8_BAR;
        }
        PG8_STAMP();
        if constexpr (!Epi::AFTER_DRAIN) { E(acc, cur, wr, wc, fr, fq); S.done(cur); }
        PG8_STAMP();
        if (!has_next) break;
#pragma unroll
        for (int a = 0; a < 2; ++a)
#pragma unroll
            for (int b = 0; b < 2; ++b)
#pragma unroll
                for (int m = 0; m < 4; ++m)
#pragma unroll
                    for (int n = 0; n < 2; ++n) acc[a][b][m][n] = (f32x4){0.f, 0.f, 0.f, 0.f};
        cur = nxt; cA = nA; cB = nB; ++ui;
    }
    PG8_WAIT_V(0);
    if (wr == 0) PG8_BAR;
    PG8_BAR;
    if constexpr (Epi::AFTER_DRAIN) { E.fused(acc, cur, wr, wc, fr, fq, lds, wid, lane); S.done(cur); }
    PG8_STAMP();
    if (STAMP && wid == 0) { stamps[lane] = lane < nts ? (((unsigned long long)(unsigned)ts_hi << 32) | (unsigned)ts_lo) : 0ull;
        if (lane == 62) stamps[62] = rt_entry; if (lane == 63) stamps[63] = (unsigned long long)wall_clock64(); }
#undef PG8_STAMP
#undef PG8_SA
#undef PG8_SB
#undef PG8_STAGE
#undef PG8_LDA
#undef PG8_LDB
#undef PG8_MMA
#undef PG8_WAIT_V
#undef PG8_WAIT_L
#undef PG8_BAR
#undef PG8_SCHED
}
}

using pg8::bf16_t; using pg8::bf16x8; using pg8::f32x4; using pg8::u32x4; using pg8::cvt_pk_bf16; using pg8::bf2f; using pg8::silu_f;
typedef unsigned u32x2 __attribute__((ext_vector_type(2)));
constexpr int DM = 1024, MPR = 16384, MSM = 128, MTOT = MPR + MSM, MP = 16640, SEQ = 2048;
constexpr int DFF = 2816, SGW = 2048;
constexpr float EPSN = 1e-6f;
constexpr int LDS_BYTES = 131072 + 64;
constexpr size_t O_Y = 0, O_SGVP = (size_t)MTOT * DM, O_SGVS = O_SGVP + (size_t)8 * 128 * 2048, O_STP = O_SGVS + (size_t)128 * 2048, O_STS = O_STP + (size_t)8 * 4 * 128 * 256;
constexpr size_t al256(size_t x) { return (x + 255) & ~(size_t)255; }
constexpr size_t W_SGIN = 0;
constexpr size_t W_SGOUT = W_SGIN + (size_t)4096 * 1024 * 2;
constexpr size_t W_13_0 = W_SGOUT + (size_t)1024 * 2048 * 2;
constexpr size_t W_2_0 = W_13_0 + (size_t)5632 * 1024 * 2;
constexpr size_t W_13_1 = W_2_0 + (size_t)1024 * 2816 * 2;
constexpr size_t W_2_1 = W_13_1 + (size_t)5632 * 1024 * 2;
constexpr size_t W_GLAIN = W_2_1 + (size_t)1024 * 2816 * 2;
constexpr size_t W_R = W_GLAIN + (size_t)3072 * 1024 * 2;
constexpr size_t W_GLAOUT = W_R + (size_t)32 * 1024 * 2;
constexpr size_t WS_HB = W_GLAOUT + (size_t)1024 * 1024 * 2;
constexpr size_t WS_R1 = WS_HB + (size_t)MP * 1024 * 2;
constexpr size_t WS_MBUF = WS_R1 + (size_t)MP * 3072 * 2;
constexpr size_t WS_RBUF = WS_R1 + (size_t)MP * 4096 * 2;
constexpr size_t WS_STATS = WS_RBUF + (size_t)MP * 16 * 4;
constexpr size_t WS_KDT = al256(WS_STATS + (size_t)MP * 32 * 2 * 4);
constexpr size_t WS_DLAST = WS_KDT + (size_t)1024 * 128 * 64 * 2;
constexpr size_t WS_STATS_S = WS_DLAST + (size_t)1024 * 128 * 4;
constexpr size_t WS_BAR = WS_STATS_S + (size_t)128 * 64 * 2 * 4;
constexpr size_t WS_END = WS_BAR + 32768;
constexpr size_t WS_QB = W_SGIN;
constexpr size_t WS_ATT = WS_QB + (size_t)MPR * 512 * 2;
static_assert(WS_END <= (size_t)256 * 1024 * 1024, "workspace too large");
static_assert((size_t)1024 * 256 * 64 * 2 <= (size_t)MP * 1024 * 2, "VT must fit the MBUF region");

struct Params {
    const float *x_prompt, *x_sample, *state_gla, *norm_g, *ffn_w13, *ffn_w2, *sg_w_in, *sg_ln_g, *sg_ln_b, *sg_w_s, *sg_b_s, *sg_w_out,
                *gla_w_in, *gla_w_gate_up, *gla_b_gate, *gla_out_norm_g, *gla_w_out;
    float* out; unsigned char* ws;
};

__device__ __forceinline__ float wave_sum(float v) {
#pragma unroll
    for (int o = 1; o < 64; o <<= 1) v += __shfl_xor(v, o);
    return v;
}
#define LDS_WAIT() asm volatile("s_waitcnt lgkmcnt(0)" ::: "memory")
__device__ __forceinline__ u32x4 frag_ld(const bf16_t* p0, size_t rs, int lane) { return *(const u32x4*)(p0 + (size_t)(lane >> 2) * rs + 8 * (lane & 3)); }
__device__ __forceinline__ bf16x8 frag_perm(const u32x4 v, int lane) {
    const int src = (4 * (lane & 15) + (lane >> 4)) * 4; u32x4 r;
    r.x = (unsigned)__builtin_amdgcn_ds_bpermute(src, (int)v.x); r.y = (unsigned)__builtin_amdgcn_ds_bpermute(src, (int)v.y);
    r.z = (unsigned)__builtin_amdgcn_ds_bpermute(src, (int)v.z); r.w = (unsigned)__builtin_amdgcn_ds_bpermute(src, (int)v.w);
    return __builtin_bit_cast(bf16x8, r); }
__device__ __forceinline__ int vbid() { extern __shared__ __attribute__((aligned(16))) unsigned char shm_[]; return (int)*(volatile __attribute__((address_space(3))) unsigned*)(__attribute__((address_space(3))) unsigned char*)(shm_ + 131072 + 16); }
__device__ __forceinline__ bool xloc() { extern __shared__ __attribute__((aligned(16))) unsigned char shm_[]; return *(volatile __attribute__((address_space(3))) unsigned*)(__attribute__((address_space(3))) unsigned char*)(shm_ + 131072 + 20) != 0u; }
__device__ __forceinline__ int xcls() { return vbid() & 7; }
__device__ __forceinline__ int xidx() { return vbid() >> 3; }
__device__ __forceinline__ int xper() { return (int)(gridDim.x >> 3); }

__device__ __forceinline__ void transpose_item(const float* __restrict__ W, int ldw, int cmax, bf16_t* __restrict__ WT, int K, int k0, int c0, int n0, float* scr, int lane) {
    const int c = c0 + (lane & 31); const bool ok = c < cmax;
#pragma unroll 8
    for (int i = 0; i < 32; ++i) { const int kk = 2 * i + (lane >> 5); scr[kk * 33 + (lane & 31)] = ok ? W[(size_t)(k0 + kk) * ldw + c] : 0.f; }
    LDS_WAIT();
    const int cc = lane & 7;
#pragma unroll
    for (int j = 0; j < 4; ++j) { const int n = (lane >> 3) + 8 * j; const float* s = scr + (8 * cc) * 33 + n;
        u32x4 o; o.x = cvt_pk_bf16(s[0 * 33], s[1 * 33]); o.y = cvt_pk_bf16(s[2 * 33], s[3 * 33]); o.z = cvt_pk_bf16(s[4 * 33], s[5 * 33]); o.w = cvt_pk_bf16(s[6 * 33], s[7 * 33]);
        *(u32x4*)(WT + (size_t)(n0 + n) * K + k0 + 8 * cc) = o; }
    LDS_WAIT();
}

__device__ __forceinline__ const float* x_in_row(const Params& p, int row) { return row < MPR ? p.x_prompt + (size_t)row * DM : p.x_sample + (size_t)(row - MPR) * DM; }

__device__ __forceinline__ void norm_row(const Params& p, int row, int lane, int mode, const float* __restrict__ g_res, const float* __restrict__ g_h, bool x_from_input) {
    const bf16_t* MB = (const bf16_t*)(p.ws + WS_MBUF); bf16_t* HB = (bf16_t*)(p.ws + WS_HB);
    bf16_t* xb = (bf16_t*)(p.out + (size_t)row * DM + DM / 2);
    f32x4 v[4];
    if (x_from_input) { const float* xin = x_in_row(p, row);
#pragma unroll
        for (int j = 0; j < 4; ++j) v[j] = *(const f32x4*)(xin + 4 * lane + 256 * j); }
    else {
#pragma unroll
        for (int j = 0; j < 4; ++j) { const u32x2 w = *(const u32x2*)(xb + 4 * lane + 256 * j);
            v[j] = (f32x4){__uint_as_float(w.x << 16), __uint_as_float(w.x & 0xffff0000u), __uint_as_float(w.y << 16), __uint_as_float(w.y & 0xffff0000u)}; } }
    if (mode != 0) {
        f32x4 mv[4]; float ss = 0.f;
#pragma unroll
        for (int j = 0; j < 4; ++j) { const u32x2 w = *(const u32x2*)(MB + (size_t)row * DM + 4 * lane + 256 * j);
            mv[j] = (f32x4){__uint_as_float(w.x << 16), __uint_as_float(w.x & 0xffff0000u), __uint_as_float(w.y << 16), __uint_as_float(w.y & 0xffff0000u)};
            ss += (mv[j][0] * mv[j][0] + mv[j][1] * mv[j][1]) + (mv[j][2] * mv[j][2] + mv[j][3] * mv[j][3]); }
        const float rs = rsqrtf(wave_sum(ss) * (1.0f / DM) + EPSN);
#pragma unroll
        for (int j = 0; j < 4; ++j) { const f32x4 g = *(const f32x4*)(g_res + 4 * lane + 256 * j); v[j] = v[j] + mv[j] * rs * g; }
        if (mode == 2) {
#pragma unroll
            for (int j = 0; j < 4; ++j) *(f32x4*)(p.out + (size_t)row * DM + 4 * lane + 256 * j) = v[j]; }
        else {
#pragma unroll
            for (int j = 0; j < 4; ++j) { u32x2 w; w.x = cvt_pk_bf16(v[j][0], v[j][1]); w.y = cvt_pk_bf16(v[j][2], v[j][3]); *(u32x2*)(xb + 4 * lane + 256 * j) = w; } }
    }
    if (mode != 2) {
        float ss = 0.f;
#pragma unroll
        for (int j = 0; j < 4; ++j) ss += (v[j][0] * v[j][0] + v[j][1] * v[j][1]) + (v[j][2] * v[j][2] + v[j][3] * v[j][3]);
        const float rs = rsqrtf(wave_sum(ss) * (1.0f / DM) + EPSN);
#pragma unroll
        for (int j = 0; j < 4; ++j) { const f32x4 g = *(const f32x4*)(g_h + 4 * lane + 256 * j); const f32x4 h = v[j] * rs * g;
            u32x2 w; w.x = cvt_pk_bf16(h[0], h[1]); w.y = cvt_pk_bf16(h[2], h[3]);
            *(u32x2*)(HB + (size_t)row * DM + 4 * lane + 256 * j) = w; }
    }
}
__device__ __forceinline__ void norm_phase(const Params& p, int mode, const float* __restrict__ g_res, const float* __restrict__ g_h, bool x_from_input) {
    const int lane = tidx() & 63, wave = tidx() >> 6;
    if (xloc()) {
        for (int rl = xidx() * 8 + wave; rl < SEQ; rl += xper() * 8) norm_row(p, xcls() * SEQ + rl, lane, mode, g_res, g_h, x_from_input);
        const int li = xidx() * 8 + wave; if (li < 16) norm_row(p, MPR + 16 * xcls() + li, lane, mode, g_res, g_h, x_from_input);
    } else {
        for (int row = vbid() * 8 + wave; row < MTOT; row += gridDim.x * 8) norm_row(p, row, lane, mode, g_res, g_h, x_from_input);
    }
}

__device__ __forceinline__ void convert_weights(const Params& p, unsigned char* lds, bool late, int gw, int NGW) {
    const int lane = tidx() & 63, wave = tidx() >> 6;
    float* scr = (float*)(lds + wave * 8704);
    constexpr int I_SGIN = 16 * 128, I_SGOUT = 32 * 32, I_13 = 16 * 176, I_2 = 44 * 32, I_GLAIN = 16 * 96, I_R = 16, I_GLAOUT = 16 * 32;
    constexpr int NITEMS = I_SGIN + I_SGOUT + 2 * I_13 + 2 * I_2 + I_GLAIN + I_R + I_GLAOUT;
    for (int it = gw; it < NITEMS; it += NGW) {
        int r = it;
        if (r < I_SGIN) { if (late) continue; const int kb = r / 128, nb = r % 128; transpose_item(p.sg_w_in, 4096, 4096, (bf16_t*)(p.ws + W_SGIN), 1024, 64 * kb, 32 * nb, 32 * nb, scr, lane); continue; } r -= I_SGIN;
        if (r < I_SGOUT) { if (late) continue; const int kb = r / 32, nb = r % 32; transpose_item(p.sg_w_out, 1024, 1024, (bf16_t*)(p.ws + W_SGOUT), 2048, 64 * kb, 32 * nb, 32 * nb, scr, lane); continue; } r -= I_SGOUT;
        if (r < 2 * I_13) { const int l = r / I_13; if (late != (l == 1)) continue; r -= l * I_13; const int kb = r / 176, nb = r % 176, n0 = 32 * nb;
            const int c0 = ((n0 >> 7) & 1) * DFF + 128 * (n0 >> 8) + (n0 & 127);
            transpose_item(p.ffn_w13 + (size_t)l * 1024 * 5632, 5632, 5632, (bf16_t*)(p.ws + (l ? W_13_1 : W_13_0)), 1024, 64 * kb, c0, n0, scr, lane); continue; } r -= 2 * I_13;
        if (r < 2 * I_2) { const int l = r / I_2; if (late != (l == 1)) continue; r -= l * I_2; const int kb = r / 32, nb = r % 32;
            transpose_item(p.ffn_w2 + (size_t)l * 2816 * 1024, 1024, 1024, (bf16_t*)(p.ws + (l ? W_2_1 : W_2_0)), 2816, 64 * kb, 32 * nb, 32 * nb, scr, lane); continue; } r -= 2 * I_2;
        if (late) continue;
        if (r < I_GLAIN) { const int kb = r / 96, nb = r % 96; transpose_item(p.gla_w_in, 3088, 3088, (bf16_t*)(p.ws + W_GLAIN), 1024, 64 * kb, 32 * nb, 32 * nb, scr, lane); continue; } r -= I_GLAIN;
        if (r < I_R) { transpose_item(p.gla_w_in, 3088, 3088, (bf16_t*)(p.ws + W_R), 1024, 64 * r, 3072, 0, scr, lane); continue; } r -= I_R;
        { const int kb = r / 32, nb = r % 32; transpose_item(p.gla_w_out, 1024, 1024, (bf16_t*)(p.ws + W_GLAOUT), 1024, 64 * kb, 32 * nb, 32 * nb, scr, lane); }
    }
}
__device__ __forceinline__ void phase0(const Params& p, unsigned char* lds) {
    const int tid = tidx(), wave = tid >> 6;
    convert_weights(p, lds, false, vbid() * 8 + wave, (int)gridDim.x * 8);
    { unsigned* hp = (unsigned*)(p.ws + WS_HB + (size_t)MTOT * DM * 2); for (int i = vbid() * 512 + tid; i < (MP - MTOT) * DM / 2; i += gridDim.x * 512) hp[i] = 0u; }
    norm_phase(p, 0, nullptr, p.norm_g, true);
}

__device__ __forceinline__ int vt_h(int vrow) { return ((vrow >> 5) & 1) | (((vrow >> 3) & 1) << 1); }
__device__ __forceinline__ void unpack8(const u32x4 w, float* f) {
    f[0] = __uint_as_float(w.x << 16); f[1] = __uint_as_float(w.x & 0xffff0000u); f[2] = __uint_as_float(w.y << 16); f[3] = __uint_as_float(w.y & 0xffff0000u);
    f[4] = __uint_as_float(w.z << 16); f[5] = __uint_as_float(w.z & 0xffff0000u); f[6] = __uint_as_float(w.w << 16); f[7] = __uint_as_float(w.w & 0xffff0000u);
}
__device__ __forceinline__ void sgu_phase(const Params& p, unsigned char* lds) {
    const int tid = tidx(), lane = tid & 63, wave = tid >> 6, fr = lane & 15, fq = lane >> 4;
    bf16_t* UB = (bf16_t*)(p.ws + WS_R1); const bf16_t* VB = (const bf16_t*)(p.ws + WS_R1 + (size_t)MP * 2048 * 2); const float* stats = (const float*)(p.ws + WS_STATS);
    const bool xaff0 = xloc();
    for (int lt = xaff0 ? xidx() * 512 + tid : vbid() * 512 + tid; lt < (xaff0 ? 16 * 256 : MSM * 256); lt += (xaff0 ? xper() : (int)gridDim.x) * 512) {
        const int task = xaff0 ? xcls() * 16 * 256 + lt : lt;
        const int r = task >> 8, col = (task & 255) * 8, g = col >> 8, row = MPR + r;
        float ssum = 0.f, sq = 0.f;
#pragma unroll
        for (int i = 0; i < 32; ++i) { const f32x4 t4 = *(const f32x4*)((const float*)(p.ws + WS_STATS_S) + (size_t)r * 128 + 4 * i); ssum += t4[0] + t4[2]; sq += t4[1] + t4[3]; }
        const float mean = ssum * (1.0f / SGW), var = sq * (1.0f / SGW) - mean * mean, rstd = rsqrtf(fmaxf(var, 0.f) + EPSN);
        float vv[8], uu[8]; unpack8(*(const u32x4*)(VB + (size_t)row * SGW + col), vv); unpack8(*(const u32x4*)(UB + (size_t)row * SGW + col), uu);
        const float w00 = p.sg_w_s[(size_t)g * 128 * 128], b0 = p.sg_b_s[g * 128];
        float vn[8], ga[8];
#pragma unroll
        for (int i = 0; i < 8; ++i) { vn[i] = (vv[i] - mean) * rstd * p.sg_ln_g[col + i] + p.sg_ln_b[col + i]; ga[i] = uu[i] * (w00 * vn[i] + b0); }
        float* so = p.out + O_SGVS + (size_t)r * SGW + col;
        *(f32x4*)so = (f32x4){vn[0], vn[1], vn[2], vn[3]}; *(f32x4*)(so + 4) = (f32x4){vn[4], vn[5], vn[6], vn[7]};
        u32x4 w; w.x = cvt_pk_bf16(ga[0], ga[1]); w.y = cvt_pk_bf16(ga[2], ga[3]); w.z = cvt_pk_bf16(ga[4], ga[5]); w.w = cvt_pk_bf16(ga[6], ga[7]);
        *(u32x4*)(UB + (size_t)row * SGW + col) = w;
    }
    unsigned char* WL = lds; unsigned char* VT = lds + 34816; pg8::f32x2* MR = (pg8::f32x2*)(lds + 104448);
    int staged_g = -1;
    const int wr = wave >> 2, wc = wave & 3;
    const bool xaff = xloc();
    for (int lu = xaff ? xidx() : (int)vbid(); lu < (xaff ? 128 : 1024); lu += xaff ? xper() : (int)gridDim.x) {
        const int unit = xaff ? xcls() * 128 + lu : lu;
        const int g = unit & 7, chunk = unit >> 3, r0 = chunk * 128, c0 = g * 256;
        __syncthreads();
        if (g != staged_g) { staged_g = g;
#pragma unroll
            for (int it = 0; it < 4; ++it) { const int idx = it * 512 + tid, t = idx >> 4, s0 = (idx & 15) * 8;
                const float* src = p.sg_w_s + ((size_t)g * 128 + t) * 128 + s0; const f32x4 a = *(const f32x4*)src, b = *(const f32x4*)(src + 4);
                float f[8] = {a[0], a[1], a[2], a[3], b[0], b[1], b[2], b[3]};
#pragma unroll
                for (int i = 0; i < 8; ++i) f[i] = (s0 + i <= t) ? f[i] : 0.f;
                u32x4 w; w.x = cvt_pk_bf16(f[0], f[1]); w.y = cvt_pk_bf16(f[2], f[3]); w.z = cvt_pk_bf16(f[4], f[5]); w.w = cvt_pk_bf16(f[6], f[7]);
                *(u32x4*)(WL + t * 272 + s0 * 2) = w; } }
        { const int rl = tid >> 2, part = tid & 3; float ssum = 0.f, sq = 0.f;
#pragma unroll
          for (int i = 0; i < 4; ++i) { const f32x4 t4 = *(const f32x4*)(stats + (size_t)(r0 + rl) * 64 + 4 * part + 16 * i); ssum += t4[0] + t4[2]; sq += t4[1] + t4[3]; }
          ssum += __shfl_xor(ssum, 1); sq += __shfl_xor(sq, 1); ssum += __shfl_xor(ssum, 2); sq += __shfl_xor(sq, 2);
          const float mean = ssum * (1.0f / SGW), rstd = rsqrtf(fmaxf(sq * (1.0f / SGW) - mean * mean, 0.f) + EPSN);
          if (part == 0) MR[rl] = (pg8::f32x2){mean, rstd}; }
        __syncthreads();
        const bool lastc = (chunk & 15) == 15; const int bb = chunk >> 4;
#pragma unroll
        for (int it = 0; it < 4; ++it) {
            const int block = it * 8 + wave, colblk = block & 3, tokblk = block >> 2, cgp = lane & 7, spl = (lane >> 3) & 3, chl = lane >> 5;
            const int s = 16 * tokblk + 8 * chl + 2 * spl, colL = 64 * colblk + 8 * cgp, rowA = r0 + s;
            float va[8], vb[8]; unpack8(*(const u32x4*)(VB + (size_t)rowA * SGW + c0 + colL), va); unpack8(*(const u32x4*)(VB + (size_t)(rowA + 1) * SGW + c0 + colL), vb);
            const f32x4 st = *(const f32x4*)(MR + s);
            const float meanA = st[0], rstdA = st[1], meanB = st[2], rstdB = st[3];
            const f32x4 g0 = *(const f32x4*)(p.sg_ln_g + c0 + colL), g1 = *(const f32x4*)(p.sg_ln_g + c0 + colL + 4), b0 = *(const f32x4*)(p.sg_ln_b + c0 + colL), b1 = *(const f32x4*)(p.sg_ln_b + c0 + colL + 4);
            const float gg[8] = {g0[0], g0[1], g0[2], g0[3], g1[0], g1[1], g1[2], g1[3]}, bbv[8] = {b0[0], b0[1], b0[2], b0[3], b1[0], b1[1], b1[2], b1[3]};
#pragma unroll
            for (int i = 0; i < 8; ++i) { va[i] = (va[i] - meanA) * rstdA * gg[i] + bbv[i]; vb[i] = (vb[i] - meanB) * rstdB * gg[i] + bbv[i]; }
            if (lastc) { float* so = p.out + O_SGVP + ((size_t)(bb * 128 + s)) * SGW + c0 + colL;
                *(f32x4*)so = (f32x4){va[0], va[1], va[2], va[3]}; *(f32x4*)(so + 4) = (f32x4){va[4], va[5], va[6], va[7]};
                *(f32x4*)(so + SGW) = (f32x4){vb[0], vb[1], vb[2], vb[3]}; *(f32x4*)(so + SGW + 4) = (f32x4){vb[4], vb[5], vb[6], vb[7]}; }
#pragma unroll
            for (int i = 0; i < 8; ++i) { const int c = colL + i; const int vrow = (c & ~63) | (((c >> 2) & 3) << 4) | (((c >> 4) & 3) << 2) | (c & 3);
                const int pch = (s >> 3) ^ vt_h(vrow);
                *(unsigned*)(VT + vrow * 272 + (pch * 8 + (s & 7)) * 2) = cvt_pk_bf16(va[i], vb[i]); }
        }
        __syncthreads();
        f32x4 acc[4][4];
#pragma unroll
        for (int a = 0; a < 4; ++a)
#pragma unroll
            for (int b = 0; b < 4; ++b) acc[a][b] = (f32x4){0.f, 0.f, 0.f, 0.f};
#pragma unroll
        for (int ks = 0; ks < 4; ++ks) {
            if (32 * ks <= 64 * wr + 63) {
                bf16x8 bfr[4];
#pragma unroll
                for (int ni = 0; ni < 4; ++ni) { const int vrow = 64 * wc + 16 * ni + fr; bfr[ni] = *(const bf16x8*)(VT + vrow * 272 + (((4 * ks + fq) ^ vt_h(vrow)) * 16)); }
#pragma unroll
                for (int mi = 0; mi < 4; ++mi) {
                    if (32 * ks <= 64 * wr + 16 * mi + 15) {
                        const bf16x8 af = *(const bf16x8*)(WL + (64 * wr + 16 * mi + fr) * 272 + (32 * ks + 8 * fq) * 2);
#pragma unroll
                        for (int ni = 0; ni < 4; ++ni) acc[mi][ni] = __builtin_amdgcn_mfma_f32_16x16x32_bf16(bfr[ni], af, acc[mi][ni], 0, 0, 0);
                    } } } }
#pragma unroll
        for (int mi = 0; mi < 4; ++mi) {
            const int t = 64 * wr + 16 * mi + fr; const float bias = p.sg_b_s[g * 128 + t];
            bf16_t* up = UB + (size_t)(r0 + t) * SGW + c0 + 64 * wc + 16 * fq;
            float u0[8], u1[8]; unpack8(*(const u32x4*)up, u0); unpack8(*(const u32x4*)(up + 8), u1);
            u32x4 w0, w1;
            w0.x = cvt_pk_bf16(u0[0] * (acc[mi][0][0] + bias), u0[1] * (acc[mi][0][1] + bias)); w0.y = cvt_pk_bf16(u0[2] * (acc[mi][0][2] + bias), u0[3] * (acc[mi][0][3] + bias));
            w0.z = cvt_pk_bf16(u0[4] * (acc[mi][1][0] + bias), u0[5] * (acc[mi][1][1] + bias)); w0.w = cvt_pk_bf16(u0[6] * (acc[mi][1][2] + bias), u0[7] * (acc[mi][1][3] + bias));
            w1.x = cvt_pk_bf16(u1[0] * (acc[mi][2][0] + bias), u1[1] * (acc[mi][2][1] + bias)); w1.y = cvt_pk_bf16(u1[2] * (acc[mi][2][2] + bias), u1[3] * (acc[mi][2][3] + bias));
            w1.z = cvt_pk_bf16(u1[4] * (acc[mi][3][0] + bias), u1[5] * (acc[mi][3][1] + bias)); w1.w = cvt_pk_bf16(u1[6] * (acc[mi][3][2] + bias), u1[7] * (acc[mi][3][3] + bias));
            *(u32x4*)up = w0; *(u32x4*)(up + 8) = w1;
        }
    }
}

__device__ __forceinline__ void gla_r_tasks(const Params& p) {
    const int lane = tidx() & 63, wave = tidx() >> 6, fr = lane & 15, fq = lane >> 4;
    const bf16_t* HB = (const bf16_t*)(p.ws + WS_HB); const bf16_t* WR = (const bf16_t*)(p.ws + W_R); float* RB = (float*)(p.ws + WS_RBUF);
    const bool xaff = xloc();
    const int ntl = xaff ? 128 + (xidx() * 8 + wave == 0 ? 1 : 0) : MTOT / 16;
    for (int tl = xaff ? xidx() * 8 + wave : (int)vbid() * 8 + wave; tl < ntl; tl += (xaff && tl + xper() * 8 >= 128 && tl < 128) ? 128 - tl : (xaff ? xper() * 8 : (int)gridDim.x * 8)) {
        const int task = xaff ? (tl < 128 ? xcls() * 128 + tl : 1024 + xcls()) : tl;
        const int row0 = task * 16; f32x4 acc = (f32x4){0.f, 0.f, 0.f, 0.f};
#pragma unroll 8
        for (int ks = 0; ks < 32; ++ks) {
            const bf16x8 a = frag_perm(frag_ld(WR + 32 * ks, DM, lane), lane), b = frag_perm(frag_ld(HB + (size_t)row0 * DM + 32 * ks, DM, lane), lane);
            acc = __builtin_amdgcn_mfma_f32_16x16x32_bf16(a, b, acc, 0, 0, 0); }
        *(f32x4*)(RB + (size_t)(row0 + fr) * 16 + 4 * fq) = acc;
    }
}
__device__ __forceinline__ float logsig16(float x) { return (fminf(x, 0.f) - __logf(1.0f + __expf(-fabsf(x)))) * (1.0f / 16.0f); }

__device__ __forceinline__ void gla_prep_phase(const Params& p, unsigned char* lds) {
    const int tid = tidx(), lane = tid & 63, wave = tid >> 6, fr = lane & 15, fq = lane >> 4;
    const bf16_t* QKVG = (const bf16_t*)(p.ws + WS_R1); const float* RB = (const float*)(p.ws + WS_RBUF);
    bf16_t* QKVGw = (bf16_t*)(p.ws + WS_R1); bf16_t* KDTg = (bf16_t*)(p.ws + WS_KDT); bf16_t* VTg = (bf16_t*)(p.ws + WS_MBUF);
    float* DL = (float*)(p.ws + WS_DLAST); bf16_t* OB = (bf16_t*)(p.ws + WS_HB);
    float* RL = (float*)lds;
    float* TOT = (float*)(lds + 4096);
    unsigned char* QL = lds + 6144;
    unsigned char* KL = lds + 6144 + 17408;
    unsigned char* VL = lds + 6144 + 2 * 17408;
    const float scale = 0.08838834764831845f;
    const bool xaff = xloc();
    for (int lu = xaff ? xidx() : (int)vbid(); lu < (xaff ? 128 : 1024); lu += xaff ? xper() : (int)gridDim.x) {
        const int u = xaff ? xcls() * 128 + lu : lu;
        const int c = u & 31, h = (u >> 5) & 3, b = u >> 7, row0 = b * SEQ + 64 * c;
        __syncthreads();
        if (tid < 256) *(f32x4*)(RL + 4 * tid) = *(const f32x4*)(RB + (size_t)row0 * 16 + 4 * tid);
        const int kc = tid & 127, tq = tid >> 7;
        float wg[16];
#pragma unroll
        for (int j = 0; j < 16; ++j) wg[j] = p.gla_w_gate_up[j * 512 + 128 * h + kc];
        const float bg = p.gla_b_gate[128 * h + kc];
        __syncthreads();
        float cum[16]; float run = 0.f;
#pragma unroll
        for (int i = 0; i < 16; ++i) { const float* rr = RL + (16 * tq + i) * 16; float x = bg;
#pragma unroll
            for (int j = 0; j < 16; ++j) x += rr[j] * wg[j];
            run += logsig16(x); cum[i] = run; }
        TOT[tq * 128 + kc] = run;
        __syncthreads();
        float off = 0.f, blast = 0.f;
#pragma unroll
        for (int q = 0; q < 4; ++q) { const float tv = TOT[q * 128 + kc]; blast += tv; off += (q < tq) ? tv : 0.f; }
        unsigned kdp[8];
#pragma unroll
        for (int i = 0; i < 16; i += 2) {
            float kd2[2];
#pragma unroll
            for (int e = 0; e < 2; ++e) { const int t = 16 * tq + i + e; const float bbv = off + cum[i + e];
                const float qv = bf2f(QKVG[(size_t)(row0 + t) * 3072 + 128 * h + kc]), kv = bf2f(QKVG[(size_t)(row0 + t) * 3072 + 512 + 128 * h + kc]);
                const float qb = qv * scale * __expf(bbv), kb = kv * __expf(-bbv); kd2[e] = kv * __expf(blast - bbv);
                const unsigned short qh = (unsigned short)(cvt_pk_bf16(qb, 0.f) & 0xffffu), kh = (unsigned short)(cvt_pk_bf16(kb, 0.f) & 0xffffu);
                *(unsigned short*)(QL + t * 272 + kc * 2) = qh; *(unsigned short*)(KL + t * 272 + kc * 2) = kh;
                QKVGw[(size_t)(row0 + t) * 3072 + 128 * h + kc] = qh; }
            kdp[i >> 1] = cvt_pk_bf16(kd2[0], kd2[1]); }
        { bf16_t* kp = KDTg + ((size_t)u * 128 + kc) * 64 + 16 * tq;
          *(u32x4*)kp = (u32x4){kdp[0], kdp[1], kdp[2], kdp[3]}; *(u32x4*)(kp + 8) = (u32x4){kdp[4], kdp[5], kdp[6], kdp[7]}; }
        if (tq == 0) DL[u * 128 + kc] = __expf(blast);
        __syncthreads();
        { const int tb = wave >> 1;
#pragma unroll
          for (int e = 0; e < 2; ++e) { const int sb = 2 * (wave & 1) + e; f32x4 acc = (f32x4){0.f, 0.f, 0.f, 0.f};
              if (sb <= tb) {
#pragma unroll
                  for (int ks = 0; ks < 4; ++ks) { const bf16x8 a = *(const bf16x8*)(KL + (16 * sb + fr) * 272 + (32 * ks + 8 * fq) * 2), bq = *(const bf16x8*)(QL + (16 * tb + fr) * 272 + (32 * ks + 8 * fq) * 2);
                      acc = __builtin_amdgcn_mfma_f32_16x16x32_bf16(a, bq, acc, 0, 0, 0); } }
              const int t = 16 * tb + fr, s0 = 16 * sb + 4 * fq;
              u32x2 w; w.x = cvt_pk_bf16(s0 + 0 <= t ? acc[0] : 0.f, s0 + 1 <= t ? acc[1] : 0.f); w.y = cvt_pk_bf16(s0 + 2 <= t ? acc[2] : 0.f, s0 + 3 <= t ? acc[3] : 0.f);
              *(u32x2*)(QKVGw + (size_t)(row0 + t) * 3072 + 512 + 128 * h + s0) = w; } }
    }
    float* AL = (float*)lds; float* QS = AL + 128; float* KS = QS + 128; float* OP = KS + 128;
    for (int lu = xaff ? xidx() : vbid(); lu < (xaff ? 64 : MSM * 4); lu += xaff ? xper() : (int)gridDim.x) {
        const int u = xaff ? xcls() * 64 + lu : lu;
        const int b = u >> 2, h = u & 3, row = MPR + b;
        __syncthreads();
        if (tid < 128) { float x = p.gla_b_gate[128 * h + tid];
#pragma unroll
            for (int j = 0; j < 16; ++j) x += RB[(size_t)row * 16 + j] * p.gla_w_gate_up[j * 512 + 128 * h + tid];
            AL[tid] = __expf(logsig16(x)); QS[tid] = bf2f(QKVG[(size_t)row * 3072 + 128 * h + tid]) * scale; KS[tid] = bf2f(QKVG[(size_t)row * 3072 + 512 + 128 * h + tid]); }
        const int j4 = (tid & 63) * 4, kq = tid >> 6;
        const u32x2 vw = *(const u32x2*)(QKVG + (size_t)row * 3072 + 1024 + 256 * h + j4);
        const f32x4 vv = (f32x4){__uint_as_float(vw.x << 16), __uint_as_float(vw.x & 0xffff0000u), __uint_as_float(vw.y << 16), __uint_as_float(vw.y & 0xffff0000u)};
        __syncthreads();
        f32x4 oacc = (f32x4){0.f, 0.f, 0.f, 0.f};
        const size_t sbase = ((size_t)(b * 4 + h) * 128) * 256 + j4;
#pragma unroll 4
        for (int i = 0; i < 16; ++i) { const int kcc = 16 * kq + i; const f32x4 s0 = *(const f32x4*)(p.state_gla + sbase + (size_t)kcc * 256);
            const f32x4 sn = s0 * AL[kcc] + vv * KS[kcc]; *(f32x4*)(p.out + O_STS + sbase + (size_t)kcc * 256) = sn; oacc = oacc + sn * QS[kcc]; }
        *(f32x4*)(OP + kq * 256 + j4) = oacc;
        __syncthreads();
        if (tid < 256) { float o = 0.f;
#pragma unroll
            for (int q = 0; q < 8; ++q) o += OP[q * 256 + tid];
            OB[(size_t)row * DM + 256 * h + tid] = (unsigned short)(cvt_pk_bf16(o, 0.f) & 0xffffu); }
    }
}

constexpr int SC_ST = 0, SC_BUF0 = 2 * 8704, SC_QB = 0, SC_ATT = 17408, SC_KDT = 17408 + 9216, SC_VT = 17408 + 9216 + 18432, SC_BUFSZ = 17408 + 9216 + 18432 + 4608;
struct ScanStage { u32x4 qb[2], att, kdt[2], vt; f32x4 dl; };
__device__ __forceinline__ void scan_stage_load(ScanStage& R, const Params& p, int pu, int row0, int h, int vs, int kcb, int fq, int tid) {
    const bf16_t* QKVG = (const bf16_t*)(p.ws + WS_R1); const bf16_t* KDTg = (const bf16_t*)(p.ws + WS_KDT); const bf16_t* VTg = (const bf16_t*)(p.ws + WS_MBUF);
    const float* DL = (const float*)(p.ws + WS_DLAST);
#pragma unroll
    for (int j = 0; j < 2; ++j) { const int idx = tid + 512 * j;
        R.qb[j] = *(const u32x4*)(QKVG + (size_t)(row0 + (idx >> 4)) * 3072 + 128 * h + 8 * (idx & 15));
        R.kdt[j] = *(const u32x4*)(KDTg + ((size_t)pu * 128 + (idx >> 3)) * 64 + 8 * (idx & 7)); }
    R.att = *(const u32x4*)(QKVG + (size_t)(row0 + (tid >> 3)) * 3072 + 512 + 128 * h + 8 * (tid & 7));
    if (tid < 256) R.vt = *(const u32x4*)(QKVG + (size_t)(row0 + (tid >> 2)) * 3072 + 1024 + 256 * h + 32 * vs + 8 * (tid & 3));
    R.dl = *(const f32x4*)(DL + pu * 128 + 16 * kcb + 4 * fq);
}
__device__ __forceinline__ void scan_stage_write(const ScanStage& R, unsigned char* buf, int tid) {
#pragma unroll
    for (int j = 0; j < 2; ++j) { const int idx = tid + 512 * j;
        *(u32x4*)(buf + SC_QB + (idx >> 4) * 272 + (idx & 15) * 16) = R.qb[j];
        *(u32x4*)(buf + SC_KDT + (idx >> 3) * 144 + (idx & 7) * 16) = R.kdt[j]; }
    *(u32x4*)(buf + SC_ATT + (tid >> 3) * 144 + (tid & 7) * 16) = R.att;
    if (tid < 256) { const int sv = tid >> 2, j0 = 8 * (tid & 3); const unsigned w[4] = {R.vt.x, R.vt.y, R.vt.z, R.vt.w};
#pragma unroll
        for (int i = 0; i < 4; ++i) { *(unsigned short*)(buf + SC_VT + (j0 + 2 * i) * 144 + sv * 2) = (unsigned short)(w[i] & 0xffffu); *(unsigned short*)(buf + SC_VT + (j0 + 2 * i + 1) * 144 + sv * 2) = (unsigned short)(w[i] >> 16); } }
}
__device__ __forceinline__ void scan_step(const unsigned char* buf, const f32x4 dl, f32x4 (&accS)[2], const unsigned char* STr, unsigned char* STw, bf16_t* OB, const ScanStage& wr, bool do_write, unsigned char* nbuf,
                                          int row0, int h, int vs, int tb, int jbo, int kcb, int fr, int fq, int tid) {
    bf16x8 vf[2][2], kdf[2];
#pragma unroll
    for (int ks = 0; ks < 2; ++ks) { kdf[ks] = *(const bf16x8*)(buf + SC_KDT + (16 * kcb + fr) * 144 + (32 * ks + 8 * fq) * 2);
#pragma unroll
        for (int jb = 0; jb < 2; ++jb) vf[jb][ks] = *(const bf16x8*)(buf + SC_VT + (16 * jb + fr) * 144 + (32 * ks + 8 * fq) * 2); }
    f32x4 acco = (f32x4){0.f, 0.f, 0.f, 0.f};
#pragma unroll
    for (int ks = 0; ks < 4; ++ks) { const bf16x8 stf = *(const bf16x8*)(STr + (16 * jbo + fr) * 272 + (32 * ks + 8 * fq) * 2), qf = *(const bf16x8*)(buf + SC_QB + (16 * tb + fr) * 272 + (32 * ks + 8 * fq) * 2);
        acco = __builtin_amdgcn_mfma_f32_16x16x32_bf16(stf, qf, acco, 0, 0, 0); }
#pragma unroll
    for (int ks = 0; ks < 2; ++ks) if (2 * ks <= tb) { const bf16x8 af = *(const bf16x8*)(buf + SC_ATT + (16 * tb + fr) * 144 + (32 * ks + 8 * fq) * 2);
        acco = __builtin_amdgcn_mfma_f32_16x16x32_bf16(jbo ? vf[1][ks] : vf[0][ks], af, acco, 0, 0, 0); }
    { u32x2 w; w.x = cvt_pk_bf16(acco[0], acco[1]); w.y = cvt_pk_bf16(acco[2], acco[3]);
      const int ln = fr + 16 * fq, src = ((ln >> 2) + 16 * (ln & 3)) * 4;
      w.x = (unsigned)__builtin_amdgcn_ds_bpermute(src, (int)w.x); w.y = (unsigned)__builtin_amdgcn_ds_bpermute(src, (int)w.y);
      *(u32x2*)(OB + (size_t)(row0 + 16 * tb + (ln >> 2)) * DM + 256 * h + 32 * vs + 16 * jbo + 4 * (ln & 3)) = w; }
#pragma unroll
    for (int jb = 0; jb < 2; ++jb) { accS[jb] = accS[jb] * dl;
#pragma unroll
        for (int ks = 0; ks < 2; ++ks) accS[jb] = __builtin_amdgcn_mfma_f32_16x16x32_bf16(kdf[ks], vf[jb][ks], accS[jb], 0, 0, 0);
        u32x2 w; w.x = cvt_pk_bf16(accS[jb][0], accS[jb][1]); w.y = cvt_pk_bf16(accS[jb][2], accS[jb][3]);
        *(u32x2*)(STw + (16 * jb + fr) * 272 + (16 * kcb + 4 * fq) * 2) = w; }
    if (do_write) scan_stage_write(wr, nbuf, tid);
    __syncthreads();
}
__device__ __forceinline__ void gla_scan_phase(const Params& p, unsigned char* lds) {
    const int tid = tidx(), lane = tid & 63, wave = tid >> 6, fr = lane & 15, fq = lane >> 4;
    bf16_t* OB = (bf16_t*)(p.ws + WS_HB);
    unsigned char* ST = lds + SC_ST; unsigned char* ST2 = lds + SC_ST + 8704; unsigned char* B0 = lds + SC_BUF0; unsigned char* B1 = lds + SC_BUF0 + SC_BUFSZ;
    const int tb = wave >> 1, jbo = wave & 1, kcb = wave;
    const bool xaff = xloc();
    for (int lu = xaff ? xidx() : vbid(); lu < (xaff ? 32 : 256); lu += xaff ? xper() : (int)gridDim.x) {
        const int u = xaff ? xcls() * 32 + lu : lu;
        const int vs = u & 7, h = (u >> 3) & 3, b = u >> 5;
        const int pu0 = (b * 4 + h) * 32, r0 = b * SEQ;
        __syncthreads();
        for (int i = tid; i < 32 * 272 / 4; i += 512) ((unsigned*)ST)[i] = 0u;
        f32x4 accS[2] = {(f32x4){0.f, 0.f, 0.f, 0.f}, (f32x4){0.f, 0.f, 0.f, 0.f}};
        ScanStage Ra, Rb;
        scan_stage_load(Ra, p, pu0, r0, h, vs, kcb, fq, tid); scan_stage_load(Rb, p, pu0 + 1, r0 + 64, h, vs, kcb, fq, tid);
        scan_stage_write(Ra, B0, tid);
        f32x4 dl_cur = Ra.dl;
        __syncthreads();
        for (int c = 0; c < 32; c += 2) {
            { const int cn = c + 2 < 32 ? c + 2 : 31; scan_stage_load(Ra, p, pu0 + cn, r0 + 64 * cn, h, vs, kcb, fq, tid); }
            const f32x4 dl_odd = Rb.dl;
            scan_step(B0, dl_cur, accS, ST, ST2, OB, Rb, true, B1, r0 + 64 * c, h, vs, tb, jbo, kcb, fr, fq, tid);
            { const int cn = c + 3 < 32 ? c + 3 : 31; scan_stage_load(Rb, p, pu0 + cn, r0 + 64 * cn, h, vs, kcb, fq, tid); }
            dl_cur = Ra.dl;
            scan_step(B1, dl_odd, accS, ST2, ST, OB, Ra, c + 2 < 32, B0, r0 + 64 * (c + 1), h, vs, tb, jbo, kcb, fr, fq, tid);
        }
#pragma unroll
        for (int jb = 0; jb < 2; ++jb)
#pragma unroll
            for (int i = 0; i < 4; ++i) p.out[O_STP + ((size_t)(b * 4 + h) * 128 + 16 * kcb + 4 * fq + i) * 256 + 32 * vs + 16 * jb + fr] = accS[jb][i];
    }
}

__device__ __forceinline__ void gla_gate_phase(const Params& p) {
    const int lane = tidx() & 63, wave = tidx() >> 6;
    bf16_t* OB = (bf16_t*)(p.ws + WS_HB); const bf16_t* QKVG = (const bf16_t*)(p.ws + WS_R1);
    const f32x4 gn = *(const f32x4*)(p.gla_out_norm_g + 4 * lane);
    const bool xaff = xloc();
    const int nrl = xaff ? SEQ + (xidx() * 8 + wave < 16 ? 1 : 0) : MTOT;
    for (int rl = xaff ? xidx() * 8 + wave : (int)vbid() * 8 + wave; rl < nrl; rl += (xaff && rl < SEQ && rl + xper() * 8 >= SEQ) ? SEQ - rl : (xaff ? xper() * 8 : (int)gridDim.x * 8)) {
        const int row = xaff ? (rl < SEQ ? xcls() * SEQ + rl : MPR + 16 * xcls() + xidx() * 8 + wave) : rl;
#pragma unroll
        for (int j = 0; j < 4; ++j) {
            const u32x2 ow = *(const u32x2*)(OB + (size_t)row * DM + 256 * j + 4 * lane), gw = *(const u32x2*)(QKVG + (size_t)row * 3072 + 2048 + 256 * j + 4 * lane);
            const f32x4 o = (f32x4){__uint_as_float(ow.x << 16), __uint_as_float(ow.x & 0xffff0000u), __uint_as_float(ow.y << 16), __uint_as_float(ow.y & 0xffff0000u)};
            const f32x4 g = (f32x4){__uint_as_float(gw.x << 16), __uint_as_float(gw.x & 0xffff0000u), __uint_as_float(gw.y << 16), __uint_as_float(gw.y & 0xffff0000u)};
            const float rs = rsqrtf(wave_sum((o[0] * o[0] + o[1] * o[1]) + (o[2] * o[2] + o[3] * o[3])) * (1.0f / 256.0f) + EPSN);
            u32x2 w; w.x = cvt_pk_bf16(o[0] * rs * gn[0] * silu_f(g[0]), o[1] * rs * gn[1] * silu_f(g[1])); w.y = cvt_pk_bf16(o[2] * rs * gn[2] * silu_f(g[2]), o[3] * rs * gn[3] * silu_f(g[3]));
            *(u32x2*)(OB + (size_t)row * DM + 256 * j + 4 * lane) = w;
        }
    }
}


struct SEpiStore { bf16_t* O; int ldc;
    __device__ __forceinline__ void operator()(int row, int col, const f32x4 (&v)[4]) const {
        u32x4 w; w.x = cvt_pk_bf16(v[0][0], v[0][1]); w.y = cvt_pk_bf16(v[0][2], v[0][3]); w.z = cvt_pk_bf16(v[1][0], v[1][1]); w.w = cvt_pk_bf16(v[1][2], v[1][3]);
        *(u32x4*)(O + (size_t)row * ldc + col) = w; } };
struct SEpiSwiglu { bf16_t* O;
    __device__ __forceinline__ void operator()(int row, int col, const f32x4 (&v)[4]) const {
        u32x4 w; w.x = cvt_pk_bf16(silu_f(v[0][0]) * v[2][0], silu_f(v[0][1]) * v[2][1]); w.y = cvt_pk_bf16(silu_f(v[0][2]) * v[2][2], silu_f(v[0][3]) * v[2][3]);
        w.z = cvt_pk_bf16(silu_f(v[1][0]) * v[3][0], silu_f(v[1][1]) * v[3][1]); w.w = cvt_pk_bf16(silu_f(v[1][2]) * v[3][2], silu_f(v[1][3]) * v[3][3]);
        *(u32x4*)(O + (size_t)row * DFF + col) = w; } };
struct SEpiSgIn { bf16_t* U; bf16_t* V; float* stats_s;
    __device__ __forceinline__ void operator()(int row, int col, const f32x4 (&v)[4]) const {
        const pg8::f32x2 a = pg8::gelu_pk((pg8::f32x2){v[0][0], v[0][1]}), b = pg8::gelu_pk((pg8::f32x2){v[0][2], v[0][3]}), c = pg8::gelu_pk((pg8::f32x2){v[1][0], v[1][1]}), d = pg8::gelu_pk((pg8::f32x2){v[1][2], v[1][3]});
        u32x4 w; w.x = cvt_pk_bf16(a.x, a.y); w.y = cvt_pk_bf16(b.x, b.y); w.z = cvt_pk_bf16(c.x, c.y); w.w = cvt_pk_bf16(d.x, d.y);
        const bool isv = col >= 2048;
        *(u32x4*)((isv ? V : U) + (size_t)row * 2048 + (col & 2047)) = w;
        float s = (a.x + a.y) + (b.x + b.y) + (c.x + c.y) + (d.x + d.y), q = (a.x * a.x + a.y * a.y) + (b.x * b.x + b.y * b.y) + (c.x * c.x + c.y * c.y) + (d.x * d.x + d.y * d.y);
        s += __shfl_xor(s, 16); s += __shfl_xor(s, 32); q += __shfl_xor(q, 16); q += __shfl_xor(q, 32);
        if (isv && (tidx() & 48) == 0) *(pg8::f32x2*)(stats_s + ((size_t)(row - MPR) * 64 + ((col - 2048) >> 5)) * 2) = (pg8::f32x2){s, q}; } };

template <int NB, int KS, int NIT, int UB, class SEpi>
__device__ __forceinline__ void skinny_gemm(unsigned char* lds, const bf16_t* __restrict__ A, const bf16_t* __restrict__ Bt, int N, int K, bool w13map, const SEpi& E, int skip_first = 0) {
    static_assert(NIT % UB == 0 && (8 % KS) == 0, "bad skinny shape");
    const int lane = tidx() & 63, wave = tidx() >> 6, fr = lane & 15, fq = lane >> 4;
    constexpr int TPW = 8 / KS;
    const int ntasks = (N / 32) * 8 / TPW;
    const int split = wave % KS, tl = wave / KS;
    f32x4* red = (f32x4*)lds;
    const bool xaff = xloc();
    if (xaff && xidx() < skip_first) return;
    for (int wt = xaff ? xidx() - skip_first : vbid(); wt < (xaff ? (N / 32) / TPW : ntasks); wt += xaff ? xper() - skip_first : (int)gridDim.x) {
        const int t = wt * TPW + tl, cg = xaff ? t : t >> 3, rb = xaff ? xcls() : t & 7;
        const int wb = w13map ? 256 * (cg >> 2) + 32 * (cg & 3) : 32 * cg;
        const int lr = lane >> 2;
        const bf16_t* ap = A + (size_t)(MPR + 16 * rb + lr) * K + (size_t)split * NIT * 32 + 8 * (lane & 3);
        const bf16_t* bp = Bt + (size_t)(wb + 8 * (lr >> 2) + (lr & 3)) * K + (size_t)split * NIT * 32 + 8 * (lane & 3);
        f32x4 acc[NB * 2];
#pragma unroll
        for (int i = 0; i < NB * 2; ++i) acc[i] = (f32x4){0.f, 0.f, 0.f, 0.f};
        for (int k0 = 0; k0 < NIT; k0 += UB) {
            u32x4 af[UB], bfv[UB][NB * 2];
#pragma unroll
            for (int u = 0; u < UB; ++u) { af[u] = *(const u32x4*)(ap + (k0 + u) * 32);
#pragma unroll
                for (int g = 0; g < NB; ++g)
#pragma unroll
                    for (int n = 0; n < 2; ++n) bfv[u][g * 2 + n] = *(const u32x4*)(bp + (size_t)(128 * g + 4 * n) * K + (k0 + u) * 32); }
#pragma unroll
            for (int u = 0; u < UB; ++u) { const bf16x8 a = frag_perm(af[u], lane);
#pragma unroll
                for (int i = 0; i < NB * 2; ++i) acc[i] = __builtin_amdgcn_mfma_f32_16x16x32_bf16(frag_perm(bfv[u][i], lane), a, acc[i], 0, 0, 0); }
        }
        if (KS > 1) {
            __syncthreads();
#pragma unroll
            for (int i = 0; i < NB * 2; ++i) red[(wave * NB * 2 + i) * 64 + lane] = acc[i];
            __syncthreads();
            if (split == 0) {
#pragma unroll
                for (int sp = 1; sp < KS; ++sp)
#pragma unroll
                    for (int i = 0; i < NB * 2; ++i) acc[i] = acc[i] + red[((wave + sp) * NB * 2 + i) * 64 + lane];
            }
        }
        if (split == 0) {
            f32x4 v[4];
#pragma unroll
            for (int i = 0; i < 4; ++i) v[i] = acc[i < NB * 2 ? i : 0];
            E(MPR + 16 * rb + fr, 32 * cg + 8 * fq, v);
        }
    }
}

#define LAS __attribute__((address_space(3)))
#define XB_TMO      128
#define XB_XCNT(j)  (256  + 64 * (j))
#define XB_XSUB(j)  (1280 + 64 * (j))
#define XB_XGEN(j)  (2304 + 64 * (j))
#define XB_TOP      3328
#define XB_TOPGEN   3392
#define XCD_BAR_WORDS 3456
#define XB_SPIN_CAP (1u << 18)

__device__ __forceinline__ unsigned xb_ld(unsigned* p)              { return __hip_atomic_load(p, __ATOMIC_RELAXED, __HIP_MEMORY_SCOPE_AGENT); }
__device__ __forceinline__ unsigned xb_add(unsigned* p, unsigned v) { return __hip_atomic_fetch_add(p, v, __ATOMIC_RELAXED, __HIP_MEMORY_SCOPE_AGENT); }
__device__ __forceinline__ unsigned xb_xcc_id() { return (unsigned)__builtin_amdgcn_s_getreg((3 << 11) | 20) & 0xFu; }
#define XB_SPIN(cond, bar) do { unsigned _sp = 0; while (cond) { __builtin_amdgcn_s_sleep(1); \
    if ((++_sp & 255u) == 0u) { if (xb_ld(&(bar)[XB_TMO])) break; if (_sp > XB_SPIN_CAP) { atomicAdd(&(bar)[XB_TMO], 1u); break; } } } } while (0)

struct XcdBarrier {
    unsigned* bar; unsigned x;
    volatile LAS unsigned* st;
};

__device__ __forceinline__ XcdBarrier xcd_barrier_post(unsigned* bar, volatile LAS unsigned* st) {
    XcdBarrier b; b.bar = bar; b.x = xb_xcc_id(); b.st = st;
    if (threadIdx.x == 0) (void)xb_add(&bar[XB_XCNT(b.x)], 1u);
    return b;
}
__device__ __forceinline__ void xcd_barrier_complete(unsigned* bar, unsigned x, unsigned& nloc, unsigned& nx) {
    const unsigned G = gridDim.x * gridDim.y * gridDim.z;
    unsigned sum, cnt, mine, sp = 0u;
    for (;;) {
        sum = 0u; cnt = 0u; mine = 0u;
#pragma unroll
        for (unsigned j = 0; j < 16; ++j) { const unsigned c = xb_ld(&bar[XB_XCNT(j)]); sum += c; cnt += (c > 0u) ? 1u : 0u; mine = (j == x) ? c : mine; }
        if (sum == G) break;
        __builtin_amdgcn_s_sleep(1);
        if ((++sp & 255u) == 0u) { if (xb_ld(&bar[XB_TMO])) break; if (sp > XB_SPIN_CAP) { atomicAdd(&bar[XB_TMO], 1u); break; } }
    }
    nloc = mine > 0u ? mine : 1u; nx = cnt > 0u ? cnt : 1u;
}

__device__ __forceinline__ void xcd_barrier(const XcdBarrier& b) {
    asm volatile("s_waitcnt vmcnt(0)" ::: "memory");
    __syncthreads();
    if (threadIdx.x == 0) {
        unsigned* bar = b.bar;
        __builtin_amdgcn_s_waitcnt(0);
        unsigned nloc = b.st[0], nx = b.st[1];
        if (nloc == 0u) { xcd_barrier_complete(bar, b.x, nloc, nx); b.st[0] = nloc; b.st[1] = nx; }
        const unsigned old = xb_add(&bar[XB_XSUB(b.x)], 1u);
        const unsigned gen = old / nloc;
        if (old + 1u == (gen + 1u) * nloc) {
            __builtin_amdgcn_fence(__ATOMIC_RELEASE, "agent");
            asm volatile("s_waitcnt vmcnt(0)" ::: "memory");
            const unsigned og = xb_add(&bar[XB_TOP], 1u);
            const unsigned tg = og / nx;
            if (og + 1u == (tg + 1u) * nx) xb_add(&bar[XB_TOPGEN], 1u);
            else XB_SPIN(xb_ld(&bar[XB_TOPGEN]) == tg, bar);
            __builtin_amdgcn_fence(__ATOMIC_ACQUIRE, "agent");
            xb_add(&bar[XB_XGEN(b.x)], 1u);
            asm volatile("s_waitcnt vmcnt(0)" ::: "memory");
        } else {
            XB_SPIN(xb_ld(&bar[XB_XGEN(b.x)]) == gen, bar);
            __builtin_amdgcn_fence(__ATOMIC_ACQUIRE, "agent");
            asm volatile("s_waitcnt vmcnt(0)" ::: "memory");
        }
    }
    __syncthreads();
}

__device__ __forceinline__ void xcc_barrier(const XcdBarrier& b) {
    asm volatile("s_waitcnt vmcnt(0)" ::: "memory");
    __syncthreads();
    if (threadIdx.x == 0) {
        unsigned* bar = b.bar; unsigned* cnt = bar + 4096 + 64 * b.x;
        const unsigned k = b.st[6], nloc = b.st[0]; b.st[6] = k + 1u;
        const unsigned target = (k + 1u) * nloc;
        (void)xb_add(cnt, 1u);
        XB_SPIN(xb_ld(cnt) < target, bar);
        __builtin_amdgcn_fence(__ATOMIC_ACQUIRE, "agent");
        asm volatile("s_waitcnt vmcnt(0)" ::: "memory");
    }
    __syncthreads();
}
#define gsync(g) xcd_barrier(xb)
#define lsync(g) do { if (xloc()) xcc_barrier(xb); else xcd_barrier(xb); } while (0)
template <class Epi> __device__ __forceinline__ void run_gemm(unsigned char* lds, const bf16_t* A, const bf16_t* Bt, int N, int K, const Epi& E) {
    pg8::Gemm g; g.A = A; g.Bt = Bt; g.M = MPR; g.N = N; g.K = K;
    pg8::StaticOrder S; S.init(MPR, N, (int)gridDim.x, vbid());
    pg8::gemm_phase<Epi, pg8::StaticOrder, false>((PG8_LAS unsigned char*)lds, g, S, E, nullptr);
}

__global__ void __launch_bounds__(512, 2) fwd_megakernel(Params p) {
    extern __shared__ __attribute__((aligned(16))) unsigned char shm[];
    cg::grid_group grid = cg::this_grid();
    unsigned char* ws = p.ws;
    bf16_t* HB = (bf16_t*)(ws + WS_HB); bf16_t* UB = (bf16_t*)(ws + WS_R1); bf16_t* VB = UB + (size_t)MP * 2048; bf16_t* MB = (bf16_t*)(ws + WS_MBUF);
    bf16_t* ACT = (bf16_t*)(ws + WS_R1); bf16_t* QKVG = (bf16_t*)(ws + WS_R1);
    const float* ng = p.norm_g;
    volatile LAS unsigned* xst = (volatile LAS unsigned*)(LAS unsigned char*)(shm + 131072);
    if (tidx() < 8) xst[tidx()] = 0u;
    __syncthreads();
    const XcdBarrier xb = xcd_barrier_post((unsigned*)(ws + WS_BAR), xst);
    unsigned my_wi = 0u;
    if (tidx() == 0) { my_wi = xb_add((unsigned*)(ws + WS_BAR) + 3520 + 64 * (xb.x & 7u), 1u); xst[4] = blockIdx.x; }
    if (p.ws == nullptr) grid.sync();
    __syncthreads();
    phase0(p, shm);
    gsync(grid);
    if (tidx() == 0) { bool ok = (gridDim.x & 7u) == 0u && xb.x < 8u;
        for (unsigned j = 0; j < 16; ++j) { const unsigned c = xb_ld((unsigned*)(ws + WS_BAR) + XB_XCNT(j)); ok = ok && (c == (j < 8u ? (gridDim.x >> 3) : 0u)); }
        if (ok) { xst[4] = my_wi * 8u + xb.x; xst[5] = 1u; } }
    __syncthreads();
    { pg8::EpiSgIn E; E.U = UB; E.V = VB; E.stats = (float*)(ws + WS_STATS); run_gemm(shm, HB, (const bf16_t*)(ws + W_SGIN), 4096, 1024, E);
      SEpiSgIn SE; SE.U = UB; SE.V = VB; SE.stats_s = (float*)(ws + WS_STATS_S); skinny_gemm<1, 2, 16, 8>(shm, HB, (const bf16_t*)(ws + W_SGIN), 4096, 1024, false, SE); }
    lsync(grid);
    sgu_phase(p, shm);
    lsync(grid);
    { pg8::EpiStoreBf16 E; E.O = MB; E.ldc = 1024; run_gemm(shm, UB, (const bf16_t*)(ws + W_SGOUT), 1024, 2048, E);
      SEpiStore SE; SE.O = MB; SE.ldc = 1024; skinny_gemm<1, 8, 8, 8>(shm, UB, (const bf16_t*)(ws + W_SGOUT), 1024, 2048, false, SE); }
    lsync(grid);
    norm_phase(p, 1, ng + 1 * DM, ng + 2 * DM, true);
    lsync(grid);
    { pg8::EpiSwiglu E; E.O = ACT; run_gemm(shm, HB, (const bf16_t*)(ws + W_13_0), 5632, 1024, E);
      SEpiSwiglu SE; SE.O = ACT; skinny_gemm<2, 2, 16, 4>(shm, HB, (const bf16_t*)(ws + W_13_0), 2816, 1024, true, SE);
      const int nu = 64 * 22, rem = nu % (int)gridDim.x;
      if (rem == 0) convert_weights(p, shm, true, vbid() * 8 + (tidx() >> 6), (int)gridDim.x * 8);
      else if (vbid() >= rem) convert_weights(p, shm, true, (vbid() - rem) * 8 + (tidx() >> 6), ((int)gridDim.x - rem) * 8); }
    lsync(grid);
    { pg8::EpiStoreBf16 E; E.O = MB; E.ldc = 1024; run_gemm(shm, ACT, (const bf16_t*)(ws + W_2_0), 1024, 2816, E);
      SEpiStore SE; SE.O = MB; SE.ldc = 1024; skinny_gemm<1, 8, 11, 11>(shm, ACT, (const bf16_t*)(ws + W_2_0), 1024, 2816, false, SE); }
    lsync(grid);
    norm_phase(p, 1, ng + 3 * DM, ng + 4 * DM, false);
    lsync(grid);
    { pg8::EpiStoreBf16 E; E.O = QKVG; E.ldc = 3072; run_gemm(shm, HB, (const bf16_t*)(ws + W_GLAIN), 3072, 1024, E);
      SEpiStore SE; SE.O = QKVG; SE.ldc = 3072; skinny_gemm<1, 2, 16, 8>(shm, HB, (const bf16_t*)(ws + W_GLAIN), 3072, 1024, false, SE); }
    gla_r_tasks(p);
    lsync(grid);
    gla_prep_phase(p, shm);
    lsync(grid);
    gla_scan_phase(p, shm);
    lsync(grid);
    gla_gate_phase(p);
    lsync(grid);
    { pg8::EpiStoreBf16 E; E.O = MB; E.ldc = 1024; run_gemm(shm, HB, (const bf16_t*)(ws + W_GLAOUT), 1024, 1024, E);
      SEpiStore SE; SE.O = MB; SE.ldc = 1024; skinny_gemm<1, 8, 4, 4>(shm, HB, (const bf16_t*)(ws + W_GLAOUT), 1024, 1024, false, SE); }
    gsync(grid);
    norm_phase(p, 1, ng + 5 * DM, ng + 6 * DM, false);
    lsync(grid);
    { pg8::EpiSwiglu E; E.O = ACT; run_gemm(shm, HB, (const bf16_t*)(ws + W_13_1), 5632, 1024, E);
      SEpiSwiglu SE; SE.O = ACT; skinny_gemm<2, 2, 16, 4>(shm, HB, (const bf16_t*)(ws + W_13_1), 2816, 1024, true, SE, (64 * 22 % (int)gridDim.x) / 8); }
    lsync(grid);
    { pg8::EpiStoreBf16 E; E.O = MB; E.ldc = 1024; run_gemm(shm, ACT, (const bf16_t*)(ws + W_2_1), 1024, 2816, E);
      SEpiStore SE; SE.O = MB; SE.ldc = 1024; skinny_gemm<1, 8, 11, 11>(shm, ACT, (const bf16_t*)(ws + W_2_1), 1024, 2816, false, SE); }
    lsync(grid);
    norm_phase(p, 2, ng + 7 * DM, nullptr, false);
}

extern "C" void kernel_launch(void* const* d_in, const int* in_sizes, int n_in, void* d_out, int out_size, void* d_ws, size_t ws_size, hipStream_t stream) {
    static int grid_blocks = 0;
    if (!grid_blocks) {
        if (n_in != 17 || ws_size < WS_END) { fprintf(stderr, "kernel_launch: unexpected n_in %d or ws_size %zu (< %zu)\n", n_in, ws_size, (size_t)WS_END); grid_blocks = -1; return; }
        int dev = 0, cus = 0, per_cu = 0;
        hipGetDevice(&dev);
        hipDeviceGetAttribute(&cus, hipDeviceAttributeMultiprocessorCount, dev);
        hipFuncSetAttribute((const void*)fwd_megakernel, hipFuncAttributeMaxDynamicSharedMemorySize, LDS_BYTES);
        hipOccupancyMaxActiveBlocksPerMultiprocessor(&per_cu, (const void*)fwd_megakernel, 512, LDS_BYTES);
        if (per_cu < 1) { fprintf(stderr, "kernel_launch: occupancy query returned %d\n", per_cu); per_cu = 1; }
        grid_blocks = cus * per_cu;
    }
    if (grid_blocks < 0) return;
    Params p{};
    p.x_prompt = (const float*)d_in[0]; p.x_sample = (const float*)d_in[1]; p.state_gla = (const float*)d_in[2]; p.norm_g = (const float*)d_in[3];
    p.ffn_w13 = (const float*)d_in[4]; p.ffn_w2 = (const float*)d_in[5]; p.sg_w_in = (const float*)d_in[6]; p.sg_ln_g = (const float*)d_in[7]; p.sg_ln_b = (const float*)d_in[8];
    p.sg_w_s = (const float*)d_in[9]; p.sg_b_s = (const float*)d_in[10]; p.sg_w_out = (const float*)d_in[11]; p.gla_w_in = (const float*)d_in[12];
    p.gla_w_gate_up = (const float*)d_in[13]; p.gla_b_gate = (const float*)d_in[14]; p.gla_out_norm_g = (const float*)d_in[15]; p.gla_w_out = (const float*)d_in[16];
    p.out = (float*)d_out; p.ws = (unsigned char*)d_ws;
    if (hipMemsetAsync((char*)d_ws + WS_BAR, 0, 32768, stream) != hipSuccess) { fprintf(stderr, "kernel_launch: memset of the barrier words failed\n"); return; }
    void* args[] = {&p};
    hipError_t e = hipLaunchCooperativeKernel((const void*)fwd_megakernel, dim3(grid_blocks), dim3(512), args, LDS_BYTES, stream);
    if (e != hipSuccess) fprintf(stderr, "cooperative launch failed: %s (grid %d)\n", hipGetErrorString(e), grid_blocks);
}
```
